# Optimizing an MI355X kernel written in HIP

```python
import jax, jax.numpy as jnp
from jax import lax
import numpy as np

D_MODEL = 1024
BATCH = 8
SEQ = 4096
DEPTH = 1

MIX_WIDTH = 2 * D_MODEL
HEAD_DIM = 128
GDN_HEADS = 6
MLSTM_HEADS = 6
MEM_HEADS = 4
GDN_W = GDN_HEADS * HEAD_DIM
MLSTM_W = MLSTM_HEADS * HEAD_DIM
MEM_W = MEM_HEADS * HEAD_DIM
N_MEM = 256
CONV_WIDTH = 4
CHUNK = 64
EPS = 1e-6
SPLITS = [GDN_W, GDN_W, GDN_W, GDN_HEADS, GDN_HEADS, GDN_W,
          MLSTM_W, MLSTM_W, MLSTM_W, MLSTM_HEADS, MLSTM_HEADS, MLSTM_W, MLSTM_W,
          MEM_W, MEM_W]
IN_COLS = 4 * GDN_W + 2 * GDN_HEADS + 5 * MLSTM_W + 2 * MLSTM_HEADS + 2 * MEM_W

kernel_name = 'hybrid_gdn_mlstm_memxattn_block'


def rms_norm(x, g):
    xf = x.astype(jnp.float32)
    y = xf * lax.rsqrt(jnp.mean(xf * xf, axis=-1, keepdims=True) + EPS)
    return y * g.astype(jnp.float32)


def l2_normalize(x):
    return x * lax.rsqrt(jnp.sum(x * x, axis=-1, keepdims=True) + EPS)


def causal_depthwise_conv(x, w):
    k = w.shape[0]
    return lax.conv_general_dilated(x, w[:, None, :], window_strides=(1,), padding=[(k - 1, 0)],
                                    dimension_numbers=('NWC', 'WIO', 'NWC'),
                                    feature_group_count=x.shape[-1])


def to_chunks(x):
    b, t, h, d = x.shape
    return x.reshape(b, t // CHUNK, CHUNK, h, d).transpose(0, 3, 1, 2, 4)


def gate_to_chunks(x):
    b, t, h = x.shape
    return x.reshape(b, t // CHUNK, CHUNK, h).transpose(0, 3, 1, 2)


def from_chunks(x):
    b, h, nc, l, d = x.shape
    return x.transpose(0, 2, 3, 1, 4).reshape(b, nc * l, h, d)


def gated_delta_rule(q, k, v, g, beta):
    b_, h_, nc, l, d = q.shape
    causal = jnp.tril(jnp.ones((l, l), dtype=bool))
    strict = jnp.tril(jnp.ones((l, l), dtype=bool), -1)
    gc = jnp.cumsum(g, axis=-1)
    g_last = gc[..., -1]
    decay = jnp.exp(jnp.where(causal, gc[..., :, None] - gc[..., None, :], -jnp.inf))
    k_beta = k * beta[..., None]
    a_mat = jnp.where(strict, jnp.einsum('bhcid,bhcjd->bhcij', k_beta, k) * decay, 0.0)
    t_mat = a_mat + jnp.eye(l, dtype=q.dtype)
    u = lax.linalg.triangular_solve(t_mat, v * beta[..., None], left_side=True, lower=True,
                                    unit_diagonal=True)
    w = lax.linalg.triangular_solve(t_mat, k_beta * jnp.exp(gc)[..., None], left_side=True,
                                    lower=True, unit_diagonal=True)
    attn = jnp.einsum('bhcid,bhcjd->bhcij', q, k) * decay
    q_dec = q * jnp.exp(gc)[..., None]
    k_dec = k * jnp.exp(g_last[..., None] - gc)[..., None]
    xs = tuple(jnp.moveaxis(t, 2, 0) for t in (q_dec, w, u, attn, k_dec, jnp.exp(g_last)))

    def step(s, inp):
        q_c, w_c, u_c, a_c, k_c, gl_c = inp
        v_new = u_c - jnp.einsum('bhld,bhde->bhle', w_c, s)
        o = jnp.einsum('bhld,bhde->bhle', q_c, s) + jnp.einsum('bhlm,bhme->bhle', a_c, v_new)
        s = s * gl_c[..., None, None] + jnp.einsum('bhld,bhle->bhde', k_c, v_new)
        return s, o

    s0 = jnp.zeros((b_, h_, d, v.shape[-1]), q.dtype)
    _, o = lax.scan(step, s0, xs)
    return jnp.moveaxis(o, 0, 2)


def mlstm_chunkwise(q, k, v, log_i, log_f):
    b_, h_, nc, l, d = q.shape
    causal = jnp.tril(jnp.ones((l, l), dtype=bool))
    bcum = jnp.cumsum(log_f, axis=-1)
    b_last = bcum[..., -1]
    log_w = jnp.where(causal, bcum[..., :, None] - bcum[..., None, :] + log_i[..., None, :], -jnp.inf)
    m_intra = jnp.max(log_w, axis=-1)
    p = jnp.exp(log_w - m_intra[..., None]) * jnp.einsum('bhctd,bhcsd->bhcts', q, k)
    num_intra = jnp.einsum('bhcts,bhcsd->bhctd', p, v)
    den_intra = jnp.sum(p, axis=-1)
    log_end = b_last[..., None] - bcum + log_i
    m_loc = jnp.max(log_end, axis=-1)
    k_end = k * jnp.exp(log_end - m_loc[..., None])[..., None]
    xs = tuple(jnp.moveaxis(t, 2, 0) for t in
               (q, k_end, v, bcum, b_last, m_intra, num_intra, den_intra, m_loc))

    def step(carry, inp):
        c_st, n_st, m_st = carry
        q_c, k_c, v_c, b_c, bl_c, mi_c, ni_c, di_c, ml_c = inp
        m_t = jnp.maximum(b_c + m_st[..., None], mi_c)
        a = jnp.exp(b_c + m_st[..., None] - m_t)
        r = jnp.exp(mi_c - m_t)
        num = a[..., None] * jnp.einsum('bhld,bhde->bhle', q_c, c_st) + r[..., None] * ni_c
        den = a * jnp.einsum('bhld,bhd->bhl', q_c, n_st) + r * di_c
        h = num / jnp.maximum(jnp.abs(den), jnp.exp(-m_t))[..., None]
        m_new = jnp.maximum(bl_c + m_st, ml_c)
        s_old = jnp.exp(bl_c + m_st - m_new)
        s_loc = jnp.exp(ml_c - m_new)
        c_st = s_old[..., None, None] * c_st + s_loc[..., None, None] * jnp.einsum('bhld,bhle->bhde', k_c, v_c)
        n_st = s_old[..., None] * n_st + s_loc[..., None] * jnp.sum(k_c, axis=-2)
        return (c_st, n_st, m_new), h

    init = (jnp.zeros((b_, h_, d, d), q.dtype), jnp.zeros((b_, h_, d), q.dtype),
            jnp.zeros((b_, h_), q.dtype))
    _, h = lax.scan(step, init, xs)
    return jnp.moveaxis(h, 0, 2)


def setup_inputs(seed: int = 0) -> dict:
    key = jax.random.key(seed)
    ks = jax.random.split(key, 16)
    f32 = jnp.float32
    nrm = jax.random.normal
    x = nrm(ks[0], (BATCH, SEQ, D_MODEL), f32)
    mem = nrm(ks[1], (BATCH, N_MEM, D_MODEL), f32)
    norm_g = 1.0 + 0.02 * nrm(ks[2], (DEPTH, D_MODEL), f32)
    w_in = nrm(ks[3], (DEPTH, D_MODEL, IN_COLS), f32) * D_MODEL ** -0.5
    conv_w = nrm(ks[4], (DEPTH, CONV_WIDTH, 3 * GDN_W), f32) * CONV_WIDTH ** -0.5
    gdn_a_log = jnp.log(jax.random.uniform(ks[5], (DEPTH, GDN_HEADS), f32, minval=1.0, maxval=16.0))
    dt = jnp.exp(jax.random.uniform(ks[6], (DEPTH, GDN_HEADS), f32,
                                    minval=math_log(1e-3), maxval=math_log(1e-1)))
    gdn_dt_bias = dt + jnp.log(-jnp.expm1(-dt))
    gdn_norm_g = 1.0 + 0.02 * nrm(ks[7], (DEPTH, HEAD_DIM), f32)
    mlstm_i_bias = 0.1 * nrm(ks[8], (DEPTH, MLSTM_HEADS), f32)
    mlstm_f_bias = jax.random.uniform(ks[9], (DEPTH, MLSTM_HEADS), f32, minval=3.0, maxval=6.0)
    mlstm_norm_g = 1.0 + 0.02 * nrm(ks[10], (DEPTH, MLSTM_HEADS, HEAD_DIM), f32)
    mem_norm_g = 1.0 + 0.02 * nrm(ks[11], (DEPTH, D_MODEL), f32)
    w_mem_kv = nrm(ks[12], (DEPTH, D_MODEL, 2 * MEM_W), f32) * D_MODEL ** -0.5
    w_out = nrm(ks[13], (DEPTH, MIX_WIDTH, D_MODEL), f32) * MIX_WIDTH ** -0.5
    final_norm_g = 1.0 + 0.02 * nrm(ks[14], (D_MODEL,), f32)
    return {'x': x, 'mem': mem, 'norm_g': norm_g, 'w_in': w_in, 'conv_w': conv_w,
            'gdn_a_log': gdn_a_log, 'gdn_dt_bias': gdn_dt_bias, 'gdn_norm_g': gdn_norm_g,
            'mlstm_i_bias': mlstm_i_bias, 'mlstm_f_bias': mlstm_f_bias, 'mlstm_norm_g': mlstm_norm_g,
            'mem_norm_g': mem_norm_g, 'w_mem_kv': w_mem_kv, 'w_out': w_out,
            'final_norm_g': final_norm_g}


def math_log(v):
    return float(np.log(v))


def reference(x, mem, norm_g, w_in, conv_w, gdn_a_log, gdn_dt_bias, gdn_norm_g,
              mlstm_i_bias, mlstm_f_bias, mlstm_norm_g, mem_norm_g, w_mem_kv, w_out,
              final_norm_g):
    f32 = jnp.float32
    bsz, seq, _ = x.shape
    split_idx = [int(c) for c in np.cumsum(SPLITS)[:-1]]
    h_res = x.astype(f32)
    for layer in range(DEPTH):
        hn = rms_norm(h_res, norm_g[layer])
        proj = hn @ w_in[layer].astype(f32)
        (g_q, g_k, g_v, g_a, g_b, g_z,
         m_q, m_k, m_v, m_i, m_f, m_o, m_z,
         x_q, x_z) = jnp.split(proj, split_idx, axis=-1)

        qkv = jax.nn.silu(causal_depthwise_conv(jnp.concatenate([g_q, g_k, g_v], axis=-1),
                                                conv_w[layer].astype(f32)))
        cq, ck, cv = jnp.split(qkv, 3, axis=-1)
        cq = l2_normalize(cq.reshape(bsz, seq, GDN_HEADS, HEAD_DIM)) * HEAD_DIM ** -0.5
        ck = l2_normalize(ck.reshape(bsz, seq, GDN_HEADS, HEAD_DIM))
        cv = cv.reshape(bsz, seq, GDN_HEADS, HEAD_DIM)
        g_log = -jnp.exp(gdn_a_log[layer].astype(f32)) * jax.nn.softplus(g_a + gdn_dt_bias[layer].astype(f32))
        beta = jax.nn.sigmoid(g_b)
        o_gdn = gated_delta_rule(to_chunks(cq), to_chunks(ck), to_chunks(cv),
                                 gate_to_chunks(g_log), gate_to_chunks(beta))
        o_gdn = rms_norm(from_chunks(o_gdn), gdn_norm_g[layer]).reshape(bsz, seq, GDN_W)
        o_gdn = o_gdn * jax.nn.silu(g_z)

        mq = m_q.reshape(bsz, seq, MLSTM_HEADS, HEAD_DIM)
        mk = m_k.reshape(bsz, seq, MLSTM_HEADS, HEAD_DIM) * HEAD_DIM ** -0.5
        mv = m_v.reshape(bsz, seq, MLSTM_HEADS, HEAD_DIM)
        log_i = m_i + mlstm_i_bias[layer].astype(f32)
        log_f = jax.nn.log_sigmoid(m_f + mlstm_f_bias[layer].astype(f32))
        h_ml = mlstm_chunkwise(to_chunks(mq), to_chunks(mk), to_chunks(mv),
                               gate_to_chunks(log_i), gate_to_chunks(log_f))
        h_ml = from_chunks(h_ml) * jax.nn.sigmoid(m_o).reshape(bsz, seq, MLSTM_HEADS, HEAD_DIM)
        h_ml = rms_norm(h_ml, mlstm_norm_g[layer]).reshape(bsz, seq, MLSTM_W)
        h_ml = h_ml * jax.nn.silu(m_z)

        mem_n = rms_norm(mem, mem_norm_g[layer])
        kv = mem_n @ w_mem_kv[layer].astype(f32)
        mem_k, mem_v = jnp.split(kv, 2, axis=-1)
        mem_k = mem_k.reshape(bsz, -1, MEM_HEADS, HEAD_DIM)
        mem_v = mem_v.reshape(bsz, -1, MEM_HEADS, HEAD_DIM)
        xq = x_q.reshape(bsz, seq, MEM_HEADS, HEAD_DIM)
        scores = jnp.einsum('bthd,bmhd->bhtm', xq, mem_k) * HEAD_DIM ** -0.5
        probs = jax.nn.softmax(scores, axis=-1)
        o_mem = jnp.einsum('bhtm,bmhd->bthd', probs, mem_v).reshape(bsz, seq, MEM_W)
        o_mem = o_mem * jax.nn.silu(x_z)

        mixed = jnp.concatenate([o_gdn, h_ml, o_mem], axis=-1)
        h_res = h_res + mixed @ w_out[layer].astype(f32)
    return rms_norm(h_res, final_norm_g).astype(x.dtype)
```

```cpp
#include <hip/hip_runtime.h>
#include <cstdio>
#include <cstdint>

#define GAS __attribute__((address_space(1)))
#define LAS __attribute__((address_space(3)))
typedef unsigned short bf16;
typedef unsigned v4u __attribute__((ext_vector_type(4)));
typedef unsigned v2u __attribute__((ext_vector_type(2)));
typedef float f32x4 __attribute__((ext_vector_type(4)));
typedef GAS unsigned gu32;
#define RLX_AGENT __ATOMIC_RELAXED, __HIP_MEMORY_SCOPE_AGENT
#define LDS_WAIT() asm volatile("s_waitcnt lgkmcnt(0)" ::: "memory")
#define VM_WAIT() asm volatile("s_waitcnt vmcnt(0)" ::: "memory")
#define DI __device__ __forceinline__

constexpr int NWAVES = 8, NTHR = 512;
#ifndef MK_N_LAUNCHES
#define MK_N_LAUNCHES 1
#endif
constexpr int PER_PHASE = 5;
constexpr int N_LAUNCHES = MK_N_LAUNCHES;

constexpr int BATCH = 8, SEQ = 4096, DM = 1024, MTOK = BATCH * SEQ, NMEM = 256, MMEM = BATCH * NMEM;
constexpr int HD = 128, NCH = 64, CH = 64;
constexpr int IN_COLS = 7960, NP = 7936, NG = 8192, NKV = 1024, KOUT = 2048;
constexpr int C_GQ = 0, C_GK = 768, C_GV = 1536, C_GZ = 2304, C_MQ = 3072, C_MK = 3840, C_MV = 4608, C_MO = 5376, C_MZ = 6144, C_XQ = 6912, C_XZ = 7424;
constexpr float EPS = 1e-6f;
constexpr float RSQRT_HD = 0.08838834764831845f;

constexpr size_t MiB = 1u << 20;
constexpr size_t WS_CTL = 0, CTL_ZERO_BYTES = 1 * MiB;
constexpr size_t WS_WOUT = 1 * MiB;
constexpr size_t WS_KV = 5 * MiB;
constexpr size_t WS_GATES = 9 * MiB;
constexpr size_t WS_PROJ = 13 * MiB;
constexpr size_t WS_END = WS_PROJ + (size_t)MTOK * NP * 2;
constexpr size_t DO_XN = 0;
constexpr size_t DO_WIN = 68 * MiB;
static_assert(DO_XN + (size_t)(MTOK + MMEM) * DM * 2 <= DO_WIN && DO_WIN + (size_t)(NG + NKV) * DM * 2 <= (size_t)MTOK * DM * 4, "d_out scratch map");
constexpr int CW_TMO = 0, CW_CODE = 1, CW_BAR = 4096;

constexpr int RING_OFF = 0, RING_BYTES = 131072;
constexpr int LDSCTL_OFF = RING_BYTES, MISC_OFF = LDSCTL_OFF + 320, XTRA_OFF = LDSCTL_OFF + 512;
constexpr int LDS_BYTES = 147456;
constexpr int XTRA_BYTES = LDS_BYTES - XTRA_OFF;

DI float bf2f(unsigned short b) { return __builtin_bit_cast(float, ((unsigned)b) << 16); }
DI float bflo(unsigned u) { return __builtin_bit_cast(float, u << 16); }
DI float bfhi(unsigned u) { return __builtin_bit_cast(float, u & 0xffff0000u); }
DI unsigned f2bf(float f) { unsigned u = __builtin_bit_cast(unsigned, f); return (u + 0x7fffu + ((u >> 16) & 1u)) >> 16; }
DI unsigned pk2(float lo, float hi) { return f2bf(lo) | (f2bf(hi) << 16); }
DI float wave_sum(float v) {
#pragma unroll
    for (int o = 1; o < 64; o <<= 1) v += __shfl_xor(v, o);
    return v;
}
DI float wave_max(float v) {
#pragma unroll
    for (int o = 1; o < 64; o <<= 1) v = fmaxf(v, __shfl_xor(v, o));
    return v;
}
DI float sigmoidf_(float x) { return 1.0f / (1.0f + __expf(-x)); }
DI float siluf_(float x) { return x / (1.0f + __expf(-x)); }
DI float softplusf_(float x) { return x > 20.f ? x : log1pf(__expf(x)); }

#define XB_TMO      128
#define XB_XCNT(j)  (256  + 64 * (j))
#define XB_XSUB(j)  (1280 + 64 * (j))
#define XB_XGEN(j)  (2304 + 64 * (j))
#define XB_TOP      3328
#define XB_TOPGEN   3392
#define XCD_BAR_WORDS 3456
#define XB_SPIN_CAP (1u << 18)
DI unsigned xb_ld(unsigned* p)              { return __hip_atomic_load(p, __ATOMIC_RELAXED, __HIP_MEMORY_SCOPE_AGENT); }
DI unsigned xb_add(unsigned* p, unsigned v) { return __hip_atomic_fetch_add(p, v, __ATOMIC_RELAXED, __HIP_MEMORY_SCOPE_AGENT); }
DI unsigned xb_xcc_id() { return (unsigned)__builtin_amdgcn_s_getreg((3 << 11) | 20) & 0xFu; }
#define XB_SPIN(cond, bar) do { unsigned _sp = 0; while (cond) { __builtin_amdgcn_s_sleep(1); \
    if ((++_sp & 255u) == 0u) { if (xb_ld(&(bar)[XB_TMO])) break; if (_sp > XB_SPIN_CAP) { atomicAdd(&(bar)[XB_TMO], 1u); break; } } } } while (0)
struct XcdBarrier { unsigned* bar; unsigned x; volatile LAS unsigned* st; };
DI XcdBarrier xcd_barrier_post(unsigned* bar, volatile LAS unsigned* st) {
    XcdBarrier b; b.bar = bar; b.x = xb_xcc_id(); b.st = st;
    if (threadIdx.x == 0) (void)xb_add(&bar[XB_XCNT(b.x)], 1u);
    return b;
}
DI void xcd_barrier_complete(unsigned* bar, unsigned x, unsigned& nloc, unsigned& nx) {
    const unsigned G = gridDim.x * gridDim.y * gridDim.z;
    unsigned sum, cnt, mine, sp = 0u;
    for (;;) {
        sum = 0u; cnt = 0u; mine = 0u;
#pragma unroll
        for (unsigned j = 0; j < 16; ++j) { const unsigned c = xb_ld(&bar[XB_XCNT(j)]); sum += c; cnt += (c > 0u) ? 1u : 0u; mine = (j == x) ? c : mine; }
        if (sum == G) break;
        __builtin_amdgcn_s_sleep(1);
        if ((++sp & 255u) == 0u) { if (xb_ld(&bar[XB_TMO])) break; if (sp > XB_SPIN_CAP) { atomicAdd(&bar[XB_TMO], 1u); break; } }
    }
    nloc = mine > 0u ? mine : 1u; nx = cnt > 0u ? cnt : 1u;
}
DI void xcd_barrier(const XcdBarrier& b) {
    asm volatile("s_waitcnt vmcnt(0)" ::: "memory");
    __syncthreads();
    if (threadIdx.x == 0) {
        unsigned* bar = b.bar;
        __builtin_amdgcn_s_waitcnt(0);
        unsigned nloc = b.st[0], nx = b.st[1];
        if (nloc == 0u) { xcd_barrier_complete(bar, b.x, nloc, nx); b.st[0] = nloc; b.st[1] = nx; }
        const unsigned old = xb_add(&bar[XB_XSUB(b.x)], 1u);
        const unsigned gen = old / nloc;
        if (old + 1u == (gen + 1u) * nloc) {
            __builtin_amdgcn_fence(__ATOMIC_RELEASE, "agent");
            asm volatile("s_waitcnt vmcnt(0)" ::: "memory");
            const unsigned og = xb_add(&bar[XB_TOP], 1u);
            const unsigned tg = og / nx;
            if (og + 1u == (tg + 1u) * nx) xb_add(&bar[XB_TOPGEN], 1u);
            else XB_SPIN(xb_ld(&bar[XB_TOPGEN]) == tg, bar);
            __builtin_amdgcn_fence(__ATOMIC_ACQUIRE, "agent");
            xb_add(&bar[XB_XGEN(b.x)], 1u);
            asm volatile("s_waitcnt vmcnt(0)" ::: "memory");
        } else {
            XB_SPIN(xb_ld(&bar[XB_XGEN(b.x)]) == gen, bar);
            __builtin_amdgcn_fence(__ATOMIC_ACQUIRE, "agent");
            asm volatile("s_waitcnt vmcnt(0)" ::: "memory");
        }
    }
    __syncthreads();
}

struct Frame {
    LAS unsigned char* lds;
    volatile LAS unsigned* MISC;
    gu32* ctl;
    int tid, lane, wave, vcu, G;
    const float *x, *mem, *norm_g, *w_in, *conv_w, *a_log, *dt_bias, *gdn_ng, *i_bias, *f_bias, *ml_ng, *mem_ng, *w_kv, *w_out, *fin_g;
    float* out;
    bf16 *XN, *WIN, *WOUT, *KV, *PROJ;
    float* GATES;
};

DI int win_old_col(int n) {
    if (n < 2304) return n;
    if (n < 5376) return n + 12;
    if (n < NP) return n + 24;
    const int c = n - NP;
    if (c < 12) return 2304 + c;
    if (c < 24) return 5388 + (c - 12);
    return -1;
}
DI void p0_transpose_item(const float* W, int K, int Nold, bf16* WT, int nblk, int mode, LAS float* scr, int item, int lane) {
    const int kb = item / nblk, nb = item % nblk, k0 = 64 * kb, n0 = 32 * nb;
    const int nn = n0 + (lane & 31);
    const int oc = mode ? win_old_col(nn) : nn;
#pragma unroll 8
    for (int i = 0; i < 32; ++i) { const int kk = 2 * i + (lane >> 5); scr[kk * 33 + (lane & 31)] = oc >= 0 ? W[(size_t)(k0 + kk) * Nold + oc] : 0.f; }
    LDS_WAIT(); asm volatile("" ::: "memory");
    const int c = lane & 7;
#pragma unroll
    for (int j = 0; j < 4; ++j) { const int n = (lane >> 3) + 8 * j; const LAS float* s = scr + (8 * c) * 33 + n;
        v4u o; o.x = pk2(s[0 * 33], s[1 * 33]); o.y = pk2(s[2 * 33], s[3 * 33]); o.z = pk2(s[4 * 33], s[5 * 33]); o.w = pk2(s[6 * 33], s[7 * 33]);
        *(GAS v4u*)(WT + (size_t)(n0 + n) * K + k0 + 8 * c) = o; }
    LDS_WAIT(); asm volatile("" ::: "memory");
}
DI void rms_row_to_bf16(int lane, const float* xrow, const float* g, bf16* orow) {
    const GAS f32x4* xr = (const GAS f32x4*)xrow + lane; const GAS f32x4* gr = (const GAS f32x4*)g + lane;
    f32x4 v[4]; float s = 0.f;
#pragma unroll
    for (int j = 0; j < 4; ++j) { v[j] = xr[64 * j]; s += (v[j].x * v[j].x + v[j].y * v[j].y) + (v[j].z * v[j].z + v[j].w * v[j].w); }
    const float rstd = 1.f / sqrtf(wave_sum(s) * (1.f / DM) + EPS);
    GAS unsigned long long* o8 = (GAS unsigned long long*)orow + lane;
#pragma unroll
    for (int j = 0; j < 4; ++j) { const f32x4 gg = gr[64 * j];
        o8[64 * j] = (unsigned long long)pk2(v[j].x * rstd * gg.x, v[j].y * rstd * gg.y) | ((unsigned long long)pk2(v[j].z * rstd * gg.z, v[j].w * rstd * gg.w) << 32); }
}
DI void p0_prologue(Frame& F) {
    LAS float* scr = (LAS float*)(F.lds + RING_OFF + F.wave * 16384);
    const int gw = F.vcu * NWAVES + F.wave, NGW = F.G * NWAVES;
    constexpr int I_IN = (DM / 64) * (NG / 32), I_KV = (DM / 64) * (NKV / 32), I_OUT = (KOUT / 64) * (DM / 32);
    for (int it = gw; it < I_IN + I_KV + I_OUT; it += NGW) {
        int r = it;
        if (r < I_IN) { p0_transpose_item(F.w_in, DM, IN_COLS, F.WIN, NG / 32, 1, scr, r, F.lane); continue; } r -= I_IN;
        if (r < I_KV) { p0_transpose_item(F.w_kv, DM, NKV, F.WIN + (size_t)NG * DM, NKV / 32, 0, scr, r, F.lane); continue; } r -= I_KV;
        p0_transpose_item(F.w_out, KOUT, DM, F.WOUT, DM / 32, 0, scr, r, F.lane);
    }
    for (int m = gw; m < MTOK + MMEM; m += NGW) {
        if (m < MTOK) rms_row_to_bf16(F.lane, F.x + (size_t)m * DM, F.norm_g, F.XN + (size_t)m * DM);
        else rms_row_to_bf16(F.lane, F.mem + (size_t)(m - MTOK) * DM, F.mem_ng, F.XN + (size_t)m * DM);
    }
}

template <class ACol, class Epi>
DI void gemm_ref_tile(Frame& F, const bf16* A, int lda, const bf16* Bt, int ldb, int m0, int n0, int K, const ACol& acol, const Epi& E) {
    LAS float* As = (LAS float*)(F.lds + RING_OFF);
    LAS float* Bs = As + 16 * 132;
    const int tid = F.tid, tx = tid & 15, ty = tid >> 4;
    float acc[4][8];
#pragma unroll
    for (int r = 0; r < 4; ++r)
#pragma unroll
        for (int c = 0; c < 8; ++c) acc[r][c] = 0.f;
    const int lrow = (tid & 255) >> 1, lch = tid & 1;
    for (int k0 = 0; k0 < K; k0 += 16) {
        v4u v;
        if (tid < 256) v = *(const GAS v4u*)(A + (size_t)(m0 + lrow) * lda + acol(k0) + lch * 8);
        else v = *(const GAS v4u*)(Bt + (size_t)(n0 + lrow) * ldb + k0 + lch * 8);
        __syncthreads();
        LAS float* dst = (tid < 256 ? As : Bs) + (lch * 8) * 132 + lrow;
        dst[0 * 132] = bflo(v.x); dst[1 * 132] = bfhi(v.x); dst[2 * 132] = bflo(v.y); dst[3 * 132] = bfhi(v.y);
        dst[4 * 132] = bflo(v.z); dst[5 * 132] = bfhi(v.z); dst[6 * 132] = bflo(v.w); dst[7 * 132] = bfhi(v.w);
        __syncthreads();
#pragma unroll 4
        for (int k = 0; k < 16; ++k) {
            const f32x4 a = *(const LAS f32x4*)(As + k * 132 + ty * 4);
            const f32x4 b0 = *(const LAS f32x4*)(Bs + k * 132 + tx * 8), b1 = *(const LAS f32x4*)(Bs + k * 132 + tx * 8 + 4);
#pragma unroll
            for (int r = 0; r < 4; ++r) {
                acc[r][0] += a[r] * b0.x; acc[r][1] += a[r] * b0.y; acc[r][2] += a[r] * b0.z; acc[r][3] += a[r] * b0.w;
                acc[r][4] += a[r] * b1.x; acc[r][5] += a[r] * b1.y; acc[r][6] += a[r] * b1.z; acc[r][7] += a[r] * b1.w; }
        }
    }
#pragma unroll
    for (int r = 0; r < 4; ++r) E(m0 + ty * 4 + r, n0 + tx * 8, acc[r]);
    __syncthreads();
}
struct AColId { DI int operator()(int k) const { return k; } };
struct AColMix { DI int operator()(int k) const { return k < 768 ? C_GV + k : (k < 1536 ? C_MV + (k - 768) : C_XQ + (k - 1536)); } };

DI float gate_transform(const Frame& F, int c, float v) {
    const int kind = c / 6, h = c - kind * 6;
    if (kind == 0) return -__expf(F.a_log[h]) * softplusf_(v + F.dt_bias[h]);
    if (kind == 1) return sigmoidf_(v);
    if (kind == 2) return v + F.i_bias[h];
    return -softplusf_(-(v + F.f_bias[h]));
}
struct EpiProjRef {
    const Frame* F;
    DI void operator()(int m, int n, const float (&v)[8]) const {
        if (m < MTOK) {
            if (n < NP) { v4u o; o.x = pk2(v[0], v[1]); o.y = pk2(v[2], v[3]); o.z = pk2(v[4], v[5]); o.w = pk2(v[6], v[7]); *(GAS v4u*)(F->PROJ + (size_t)m * NP + n) = o; }
            else {
#pragma unroll
                for (int j = 0; j < 8; ++j) { const int c = n - NP + j; if (c < 24) F->GATES[(size_t)m * 32 + c] = gate_transform(*F, c, v[j]); }
            }
        } else {
            v4u o; o.x = pk2(v[0], v[1]); o.y = pk2(v[2], v[3]); o.z = pk2(v[4], v[5]); o.w = pk2(v[6], v[7]);
            *(GAS v4u*)(F->KV + (size_t)(m - MTOK) * NKV + (n - NG)) = o;
        }
    }
};
struct EpiOutRef {
    const Frame* F;
    DI void operator()(int m, int n, const float (&v)[8]) const {
        const GAS f32x4* xr = (const GAS f32x4*)(F->x + (size_t)m * DM + n);
        const f32x4 x0 = xr[0], x1 = xr[1];
        GAS f32x4* o = (GAS f32x4*)(F->out + (size_t)m * DM + n);
        o[0] = (f32x4){x0.x + v[0], x0.y + v[1], x0.z + v[2], x0.w + v[3]};
        o[1] = (f32x4){x1.x + v[4], x1.y + v[5], x1.z + v[6], x1.w + v[7]};
    }
};
DI void p1_gemm_in_ref(Frame& F) {
    constexpr int T1 = (MTOK / 128) * (NG / 128), T2 = (MMEM / 128) * (NKV / 128);
    EpiProjRef E{&F};
    for (int L = F.vcu; L < T1 + T2; L += F.G) {
        int m0, n0;
        if (L < T1) { m0 = (L / (NG / 128)) * 128; n0 = (L % (NG / 128)) * 128; }
        else { const int r = L - T1; m0 = MTOK + (r / (NKV / 128)) * 128; n0 = NG + (r % (NKV / 128)) * 128; }
        gemm_ref_tile(F, F.XN, DM, F.WIN, DM, m0, n0, DM, AColId{}, E);
    }
}
DI void p3_gemm_out_ref(Frame& F) {
    constexpr int T1 = (MTOK / 128) * (DM / 128);
    EpiOutRef E{&F};
    for (int L = F.vcu; L < T1; L += F.G) {
        const int m0 = (L / (DM / 128)) * 128, n0 = (L % (DM / 128)) * 128;
        gemm_ref_tile(F, F.PROJ, NP, F.WOUT, KOUT, m0, n0, KOUT, AColMix{}, E);
    }
}
DI void p4_final_norm(Frame& F) {
    const int gw = F.vcu * NWAVES + F.wave, NGW = F.G * NWAVES;
    for (int m = gw; m < MTOK; m += NGW) {
        GAS f32x4* yr = (GAS f32x4*)(F.out + (size_t)m * DM) + F.lane; const GAS f32x4* gr = (const GAS f32x4*)F.fin_g + F.lane;
        f32x4 v[4]; float s = 0.f;
#pragma unroll
        for (int j = 0; j < 4; ++j) { v[j] = yr[64 * j]; s += (v[j].x * v[j].x + v[j].y * v[j].y) + (v[j].z * v[j].z + v[j].w * v[j].w); }
        const float rstd = 1.f / sqrtf(wave_sum(s) * (1.f / DM) + EPS);
#pragma unroll
        for (int j = 0; j < 4; ++j) { const f32x4 gg = gr[64 * j]; yr[64 * j] = (f32x4){v[j].x * rstd * gg.x, v[j].y * rstd * gg.y, v[j].z * rstd * gg.z, v[j].w * rstd * gg.w}; }
    }
}

DI void gdn_ref_item(Frame& F, int item) {
    const int b = item / 6, h = item % 6, tid = F.tid, lane = F.lane, wave = F.wave;
    LAS float* QKV = (LAS float*)(F.lds + RING_OFF);
    LAS float* OB = (LAS float*)(F.lds + RING_OFF + 98304);
    LAS bf16* HALOV = (LAS bf16*)(F.lds + XTRA_OFF);
    LAS float* AT = (LAS float*)(F.lds + XTRA_OFF + 768);
    LAS float* BT = AT + 64;
    float S[128];
#pragma unroll
    for (int d = 0; d < 128; ++d) S[d] = 0.f;
    for (int c = 0; c < NCH; ++c) {
        const int m0 = b * SEQ + c * CH;
#pragma unroll 1
        for (int i = 0; i < 48; ++i) {
            const int idx = tid + NTHR * i, t = idx / 384, cc = idx - t * 384, seg = cc >> 7, d = cc & 127;
            const int col = seg * 768 + h * 128 + d;
            float y = 0.f;
#pragma unroll
            for (int j = 0; j < 4; ++j) {
                const int tt = c * CH + t + j - 3;
                if (tt >= 0) {
                    float xv;
                    if (seg == 2 && tt < c * CH) xv = bf2f(HALOV[(tt - (c * CH - 3)) * 128 + d]);
                    else xv = bf2f(F.PROJ[(size_t)(b * SEQ + tt) * NP + col]);
                    y += F.conv_w[j * 2304 + col] * xv;
                }
            }
            QKV[t * 384 + cc] = siluf_(y);
        }
        __syncthreads();
#pragma unroll 1
        for (int i = 0; i < 16; ++i) {
            const int p = wave * 16 + i, t = p >> 1, seg = p & 1;
            LAS float* r = QKV + t * 384 + seg * 128;
            const float v0 = r[lane], v1 = r[lane + 64];
            const float ss = wave_sum(v0 * v0 + v1 * v1);
            const float sc = (1.f / sqrtf(ss + EPS)) * (seg == 0 ? RSQRT_HD : 1.f);
            r[lane] = v0 * sc; r[lane + 64] = v1 * sc;
        }
        if (tid < 64) { AT[tid] = __expf(F.GATES[(size_t)(m0 + tid) * 32 + h]); BT[tid] = F.GATES[(size_t)(m0 + tid) * 32 + 6 + h]; }
        if (tid < 384) { const int r = tid >> 7, d = tid & 127; HALOV[r * 128 + d] = F.PROJ[(size_t)(m0 + 61 + r) * NP + C_GV + h * 128 + d]; }
        __syncthreads();
        if (tid < 128) {
            const int e = tid;
#pragma unroll 1
            for (int t = 0; t < CH; ++t) {
                const LAS float* q = QKV + t * 384; const LAS float* k = q + 128;
                const float a = AT[t], be = BT[t], v = q[256 + e];
                float r = 0.f;
#pragma unroll
                for (int db = 0; db < 128; db += 16) {
#pragma unroll
                    for (int d = 0; d < 16; ++d) r += k[db + d] * S[db + d];
                    asm volatile("" ::: "memory");
                }
                const float vn = be * (v - a * r);
                float o = 0.f;
#pragma unroll
                for (int db = 0; db < 128; db += 16) {
#pragma unroll
                    for (int d = 0; d < 16; ++d) { S[db + d] = a * S[db + d] + k[db + d] * vn; o += q[db + d] * S[db + d]; }
                    asm volatile("" ::: "memory");
                }
                OB[t * 128 + e] = o;
            }
        }
        __syncthreads();
#pragma unroll 1
        for (int i = 0; i < 8; ++i) {
            const int t = wave + 8 * i;
            const float o0 = OB[t * 128 + lane], o1 = OB[t * 128 + 64 + lane];
            const float rstd = 1.f / sqrtf(wave_sum(o0 * o0 + o1 * o1) * (1.f / 128.f) + EPS);
            const size_t row = (size_t)(m0 + t) * NP;
            const float z0 = bf2f(F.PROJ[row + C_GZ + h * 128 + lane]), z1 = bf2f(F.PROJ[row + C_GZ + h * 128 + 64 + lane]);
            F.PROJ[row + C_GV + h * 128 + lane] = (bf16)f2bf(o0 * rstd * F.gdn_ng[lane] * siluf_(z0));
            F.PROJ[row + C_GV + h * 128 + 64 + lane] = (bf16)f2bf(o1 * rstd * F.gdn_ng[64 + lane] * siluf_(z1));
        }
        __syncthreads();
    }
}
DI void mlstm_ref_item(Frame& F, int item) {
    const int b = item / 6, h = item % 6, tid = F.tid, lane = F.lane, wave = F.wave;
    LAS float* QKV = (LAS float*)(F.lds + RING_OFF);
    LAS float* NUM = (LAS float*)(F.lds + RING_OFF + 98304);
    LAS float* FT = (LAS float*)(F.lds + XTRA_OFF);
    LAS float* IT = FT + 64;
    LAS float* DEN = IT + 64;
    float C[128];
#pragma unroll
    for (int d = 0; d < 128; ++d) C[d] = 0.f;
    float n0 = 0.f, n1 = 0.f;
    for (int c = 0; c < NCH; ++c) {
        const int m0 = b * SEQ + c * CH;
#pragma unroll 2
        for (int i = 0; i < 48; ++i) {
            const int idx = tid + NTHR * i, t = idx / 384, cc = idx - t * 384, seg = cc >> 7, d = cc & 127;
            float v = bf2f(F.PROJ[(size_t)(m0 + t) * NP + C_MQ + seg * 768 + h * 128 + d]);
            if (seg == 1) v *= RSQRT_HD;
            QKV[t * 384 + cc] = v;
        }
        if (tid < 64) { FT[tid] = __expf(F.GATES[(size_t)(m0 + tid) * 32 + 18 + h]); IT[tid] = __expf(F.GATES[(size_t)(m0 + tid) * 32 + 12 + h]); }
        __syncthreads();
        if (tid < 128) {
            const int e = tid;
#pragma unroll 1
            for (int t = 0; t < CH; ++t) {
                const LAS float* q = QKV + t * 384; const LAS float* k = q + 128;
                const float f = FT[t], iv = IT[t] * q[256 + e];
                float num = 0.f;
#pragma unroll
                for (int db = 0; db < 128; db += 16) {
#pragma unroll
                    for (int d = 0; d < 16; ++d) { C[db + d] = f * C[db + d] + iv * k[db + d]; num += q[db + d] * C[db + d]; }
                    asm volatile("" ::: "memory");
                }
                NUM[t * 128 + e] = num;
            }
        } else if (tid < 192) {
#pragma unroll 1
            for (int t = 0; t < CH; ++t) {
                const LAS float* q = QKV + t * 384; const LAS float* k = q + 128;
                const float f = FT[t], ig = IT[t];
                n0 = f * n0 + ig * k[lane]; n1 = f * n1 + ig * k[lane + 64];
                const float den = wave_sum(q[lane] * n0 + q[lane + 64] * n1);
                if (lane == 0) DEN[t] = den;
            }
        }
        __syncthreads();
#pragma unroll 1
        for (int i = 0; i < 8; ++i) {
            const int t = wave + 8 * i;
            const size_t row = (size_t)(m0 + t) * NP;
            const float dn = 1.f / fmaxf(fabsf(DEN[t]), 1.f);
            const float g0 = sigmoidf_(bf2f(F.PROJ[row + C_MO + h * 128 + lane])), g1 = sigmoidf_(bf2f(F.PROJ[row + C_MO + h * 128 + 64 + lane]));
            const float h0 = NUM[t * 128 + lane] * dn * g0, h1 = NUM[t * 128 + 64 + lane] * dn * g1;
            const float rstd = 1.f / sqrtf(wave_sum(h0 * h0 + h1 * h1) * (1.f / 128.f) + EPS);
            const float z0 = bf2f(F.PROJ[row + C_MZ + h * 128 + lane]), z1 = bf2f(F.PROJ[row + C_MZ + h * 128 + 64 + lane]);
            F.PROJ[row + C_MV + h * 128 + lane] = (bf16)f2bf(h0 * rstd * F.ml_ng[h * 128 + lane] * siluf_(z0));
            F.PROJ[row + C_MV + h * 128 + 64 + lane] = (bf16)f2bf(h1 * rstd * F.ml_ng[h * 128 + 64 + lane] * siluf_(z1));
        }
        __syncthreads();
    }
}
DI void xattn_ref_item(Frame& F, int item) {
    const int tile = item & 31, h = (item >> 5) & 3, b = item >> 7, tid = F.tid, lane = F.lane, wave = F.wave;
    LAS bf16* Ks = (LAS bf16*)(F.lds + RING_OFF);
    LAS bf16* Vs = Ks + 256 * 128;
    LAS float* qs = (LAS float*)(F.lds + XTRA_OFF + wave * 1536);
    LAS float* ps = qs + 128;
    __syncthreads();
    for (int i = 0; i < 16; ++i) {
        const int idx = tid + NTHR * i, mat = idx >> 12, r = (idx >> 4) & 255, ch = idx & 15;
        const v4u v = *(const GAS v4u*)(F.KV + (size_t)(b * NMEM + r) * NKV + mat * 512 + h * 128 + ch * 8);
        *(LAS v4u*)((mat ? Vs : Ks) + r * 128 + ((ch ^ (r & 15)) * 8)) = v;
    }
    __syncthreads();
#pragma unroll 1
    for (int tt = 0; tt < 16; ++tt) {
        const size_t row = (size_t)(b * SEQ + tile * 128 + wave * 16 + tt) * NP;
        const unsigned qq = *(const GAS unsigned*)(F.PROJ + row + C_XQ + h * 128 + 2 * lane);
        qs[2 * lane] = bflo(qq); qs[2 * lane + 1] = bfhi(qq);
        LDS_WAIT();
        float s[4];
#pragma unroll
        for (int r4 = 0; r4 < 4; ++r4) {
            const int r = lane + 64 * r4; float acc = 0.f;
#pragma unroll
            for (int ch = 0; ch < 16; ++ch) {
                const v4u kv = *(const LAS v4u*)(Ks + r * 128 + ((ch ^ (r & 15)) * 8));
                const f32x4 q0 = *(const LAS f32x4*)(qs + ch * 8), q1 = *(const LAS f32x4*)(qs + ch * 8 + 4);
                acc += q0.x * bflo(kv.x) + q0.y * bfhi(kv.x) + q0.z * bflo(kv.y) + q0.w * bfhi(kv.y) + q1.x * bflo(kv.z) + q1.y * bfhi(kv.z) + q1.z * bflo(kv.w) + q1.w * bfhi(kv.w);
            }
            s[r4] = acc * RSQRT_HD;
        }
        const float mx = wave_max(fmaxf(fmaxf(s[0], s[1]), fmaxf(s[2], s[3])));
        float l = 0.f;
#pragma unroll
        for (int r4 = 0; r4 < 4; ++r4) { const float p = __expf(s[r4] - mx); ps[lane + 64 * r4] = p; l += p; }
        l = wave_sum(l);
        LDS_WAIT();
        float o0 = 0.f, o1 = 0.f;
        const int chv = lane >> 2, sub = 2 * (lane & 3);
#pragma unroll 4
        for (int r = 0; r < 256; ++r) {
            const float p = ps[r];
            const unsigned vv = *(const LAS unsigned*)(Vs + r * 128 + ((chv ^ (r & 15)) * 8) + sub);
            o0 += p * bflo(vv); o1 += p * bfhi(vv);
        }
        const float il = 1.f / l;
        const unsigned zz = *(const GAS unsigned*)(F.PROJ + row + C_XZ + h * 128 + 2 * lane);
        *(GAS unsigned*)(F.PROJ + row + C_XQ + h * 128 + 2 * lane) = pk2(o0 * il * siluf_(bflo(zz)), o1 * il * siluf_(bfhi(zz)));
        LDS_WAIT();
    }
}
DI void p2_mixers_ref(Frame& F) {
    if (F.G < 128) return;
    if (F.vcu < 48) gdn_ref_item(F, F.vcu);
    else if (F.vcu < 96) mlstm_ref_item(F, F.vcu - 48);
    else for (int it = F.vcu - 96; it < BATCH * 4 * 32; it += F.G - 96) xattn_ref_item(F, it);
}

struct Args { const float* in[15]; float* out; unsigned char* ws; int ph_lo, ph_hi, li, pad; };
__global__ void __launch_bounds__(NTHR, 2) hyb_fwd(Args args) {
    extern __shared__ __attribute__((aligned(16))) unsigned char lds[];
    Frame F;
    F.lds = (LAS unsigned char*)lds;
    F.MISC = (volatile LAS unsigned*)(F.lds + MISC_OFF);
    F.tid = threadIdx.x; F.lane = F.tid & 63; F.wave = __builtin_amdgcn_readfirstlane(F.tid >> 6);
    F.G = gridDim.x; { const int bx = blockIdx.x; F.vcu = (F.G % 8 == 0) ? (bx % 8) * (F.G / 8) + bx / 8 : bx; }
    unsigned char* ws = args.ws;
    F.ctl = (gu32*)(ws + WS_CTL);
    F.x = args.in[0]; F.mem = args.in[1]; F.norm_g = args.in[2]; F.w_in = args.in[3]; F.conv_w = args.in[4]; F.a_log = args.in[5]; F.dt_bias = args.in[6];
    F.gdn_ng = args.in[7]; F.i_bias = args.in[8]; F.f_bias = args.in[9]; F.ml_ng = args.in[10]; F.mem_ng = args.in[11]; F.w_kv = args.in[12]; F.w_out = args.in[13]; F.fin_g = args.in[14];
    F.out = args.out;
    F.XN = (bf16*)((unsigned char*)args.out + DO_XN); F.WIN = (bf16*)((unsigned char*)args.out + DO_WIN);
    F.WOUT = (bf16*)(ws + WS_WOUT); F.KV = (bf16*)(ws + WS_KV); F.GATES = (float*)(ws + WS_GATES); F.PROJ = (bf16*)(ws + WS_PROJ);
    for (int u = F.tid; u < (XTRA_OFF - LDSCTL_OFF) / 4; u += NTHR) ((LAS unsigned*)(F.lds + LDSCTL_OFF))[u] = 0u;
    __syncthreads();
    XcdBarrier bar; bar.bar = (unsigned*)(F.ctl + CW_BAR); bar.x = 0; bar.st = nullptr;
    if (N_LAUNCHES != PER_PHASE) bar = xcd_barrier_post((unsigned*)(F.ctl + CW_BAR), F.MISC + 8);
#define GRID_BAR(seam) do { if (N_LAUNCHES == PER_PHASE) { if (F.tid == 0) __hip_atomic_store(F.ctl + CW_TMO, 0xBADBA0u | (unsigned)(seam), RLX_AGENT); } else { xcd_barrier(bar); } } while (0)
    const int lo = args.ph_lo, hi = args.ph_hi;
#define IN(k) (lo <= (k) && (k) < hi)
#define BOTH(k) (IN(k) && IN((k) + 1))
    if (IN(0)) { p0_prologue(F); if (BOTH(0)) GRID_BAR(0); }
    if (IN(1)) { p1_gemm_in_ref(F); if (BOTH(1)) GRID_BAR(1); }
    if (IN(2)) { p2_mixers_ref(F); if (BOTH(2)) GRID_BAR(2); }
    if (IN(3)) { p3_gemm_out_ref(F); if (BOTH(3)) GRID_BAR(3); }
    if (IN(4)) { p4_final_norm(F); }
#undef IN
#undef BOTH
}

extern "C" void kernel_launch(void* const* d_in, const int* in_sizes, int n_in, void* d_out, int out_size, void* d_ws, size_t ws_size, hipStream_t stream) {
    static int grid = 0;
    if (grid == 0) {
        if (n_in != 15 || in_sizes[0] != MTOK * DM || out_size != MTOK * DM || ws_size < WS_END) { fprintf(stderr, "kernel_launch: unexpected shapes / workspace (%zu < %zu)\n", ws_size, (size_t)WS_END); grid = -1; return; }
        int dev = 0, cus = 0, per_cu = 0;
        if (hipGetDevice(&dev) != hipSuccess || hipDeviceGetAttribute(&cus, hipDeviceAttributeMultiprocessorCount, dev) != hipSuccess) { grid = -1; return; }
        if (hipFuncSetAttribute((const void*)hyb_fwd, hipFuncAttributeMaxDynamicSharedMemorySize, LDS_BYTES) != hipSuccess) { grid = -1; return; }
        if (hipOccupancyMaxActiveBlocksPerMultiprocessor(&per_cu, (const void*)hyb_fwd, NTHR, LDS_BYTES) != hipSuccess || per_cu < 1)
            fprintf(stderr, "kernel_launch: occupancy query reports %d workgroups per CU\n", per_cu);
        (void)hipGetLastError();
        grid = cus;
    }
    if (grid < 0) return;
    if (hipMemsetAsync((char*)d_ws + WS_CTL, 0, CTL_ZERO_BYTES, stream) != hipSuccess) return;
    Args a{};
    for (int i = 0; i < 15; ++i) a.in[i] = (const float*)d_in[i];
    a.out = (float*)d_out; a.ws = (unsigned char*)d_ws;
    const int nl = N_LAUNCHES == PER_PHASE ? PER_PHASE : 1;
    for (int li = 0; li < nl; ++li) {
        a.ph_lo = (N_LAUNCHES == PER_PHASE) ? li : 0; a.ph_hi = (N_LAUNCHES == PER_PHASE) ? li + 1 : PER_PHASE; a.li = li;
        hipLaunchKernelGGL(hyb_fwd, dim3(grid), dim3(NTHR), LDS_BYTES, stream, a);
        if (hipPeekAtLastError() != hipSuccess) break;
    }
}
```

```cpp
#include <hip/hip_runtime.h>
#include <cstdio>
#include <cstdint>

#define GAS __attribute__((address_space(1)))
#define LAS __attribute__((address_space(3)))
typedef unsigned short bf16;
typedef unsigned v4u __attribute__((ext_vector_type(4)));
typedef unsigned v2u __attribute__((ext_vector_type(2)));
typedef float f32x4 __attribute__((ext_vector_type(4)));
typedef GAS unsigned gu32;
#define RLX_AGENT __ATOMIC_RELAXED, __HIP_MEMORY_SCOPE_AGENT
#define LDS_WAIT() asm volatile("s_waitcnt lgkmcnt(0)" ::: "memory")
#define VM_WAIT() asm volatile("s_waitcnt vmcnt(0)" ::: "memory")
#define DI __device__ __forceinline__

constexpr int NWAVES = 8, NTHR = 512;
#ifndef MK_N_LAUNCHES
#define MK_N_LAUNCHES 1
#endif
constexpr int PER_PHASE = 5;
constexpr int N_LAUNCHES = MK_N_LAUNCHES;

constexpr int BATCH = 8, SEQ = 4096, DM = 1024, MTOK = BATCH * SEQ, NMEM = 256, MMEM = BATCH * NMEM;
constexpr int HD = 128, NCH = 64, CH = 64;
constexpr int IN_COLS = 7960, NP = 7936, NG = 8192, NKV = 1024, KOUT = 2048;
constexpr int C_GQ = 0, C_GK = 768, C_GV = 1536, C_GZ = 2304, C_MQ = 3072, C_MK = 3840, C_MV = 4608, C_MO = 5376, C_MZ = 6144, C_XQ = 6912, C_XZ = 7424;
constexpr float EPS = 1e-6f;
constexpr float RSQRT_HD = 0.08838834764831845f;

constexpr size_t MiB = 1u << 20;
constexpr size_t WS_CTL = 0, CTL_ZERO_BYTES = 1 * MiB;
constexpr size_t WS_WOUT = 1 * MiB;
constexpr size_t WS_KV = 5 * MiB;
constexpr size_t WS_GATES = 9 * MiB;
constexpr size_t WS_PROJ = 13 * MiB;
constexpr size_t WS_END = WS_PROJ + (size_t)MTOK * NP * 2;
constexpr size_t DO_XN = 0;
constexpr size_t DO_WIN = 68 * MiB;
static_assert(DO_WIN == (size_t)(MTOK + MMEM) * DM * 2, "WIN follows XN");
static_assert(DO_XN + (size_t)(MTOK + MMEM) * DM * 2 <= DO_WIN && DO_WIN + (size_t)(NG + NKV) * DM * 2 <= (size_t)MTOK * DM * 4, "d_out scratch map");
constexpr size_t DO_CHK = 0;
constexpr size_t DO_HALO = 96 * MiB;
constexpr int CW_TMO = 0, CW_CODE = 1, CW_BAR = 4096;

constexpr int RING_OFF = 0, RING_BYTES = 131072;
constexpr int LDSCTL_OFF = RING_BYTES, MISC_OFF = LDSCTL_OFF + 320, XTRA_OFF = LDSCTL_OFF + 512;
constexpr int LDS_BYTES = 147456;
constexpr int XTRA_BYTES = LDS_BYTES - XTRA_OFF;

DI float bf2f(unsigned short b) { return __builtin_bit_cast(float, ((unsigned)b) << 16); }
DI float bflo(unsigned u) { return __builtin_bit_cast(float, u << 16); }
DI float bfhi(unsigned u) { return __builtin_bit_cast(float, u & 0xffff0000u); }
DI unsigned f2bf(float f) { unsigned u = __builtin_bit_cast(unsigned, f); return (u + 0x7fffu + ((u >> 16) & 1u)) >> 16; }
DI unsigned pk2(float lo, float hi) { return f2bf(lo) | (f2bf(hi) << 16); }
DI float wave_sum(float v) {
#pragma unroll
    for (int o = 1; o < 64; o <<= 1) v += __shfl_xor(v, o);
    return v;
}
DI float wave_max(float v) {
#pragma unroll
    for (int o = 1; o < 64; o <<= 1) v = fmaxf(v, __shfl_xor(v, o));
    return v;
}
DI float sigmoidf_(float x) { return 1.0f / (1.0f + __expf(-x)); }
DI float siluf_(float x) { return x / (1.0f + __expf(-x)); }
DI float softplusf_(float x) { return x > 20.f ? x : log1pf(__expf(x)); }

#define XB_TMO      128
#define XB_XCNT(j)  (256  + 64 * (j))
#define XB_XSUB(j)  (1280 + 64 * (j))
#define XB_XGEN(j)  (2304 + 64 * (j))
#define XB_TOP      3328
#define XB_TOPGEN   3392
#define XCD_BAR_WORDS 3456
#define XB_SPIN_CAP (1u << 18)
DI unsigned xb_ld(unsigned* p)              { return __hip_atomic_load(p, __ATOMIC_RELAXED, __HIP_MEMORY_SCOPE_AGENT); }
DI unsigned xb_add(unsigned* p, unsigned v) { return __hip_atomic_fetch_add(p, v, __ATOMIC_RELAXED, __HIP_MEMORY_SCOPE_AGENT); }
DI unsigned xb_xcc_id() { return (unsigned)__builtin_amdgcn_s_getreg((3 << 11) | 20) & 0xFu; }
#define XB_SPIN(cond, bar) do { unsigned _sp = 0; while (cond) { __builtin_amdgcn_s_sleep(1); \
    if ((++_sp & 255u) == 0u) { if (xb_ld(&(bar)[XB_TMO])) break; if (_sp > XB_SPIN_CAP) { atomicAdd(&(bar)[XB_TMO], 1u); break; } } } } while (0)
struct XcdBarrier { unsigned* bar; unsigned x; volatile LAS unsigned* st; };
DI XcdBarrier xcd_barrier_post(unsigned* bar, volatile LAS unsigned* st) {
    XcdBarrier b; b.bar = bar; b.x = xb_xcc_id(); b.st = st;
    if (threadIdx.x == 0) (void)xb_add(&bar[XB_XCNT(b.x)], 1u);
    return b;
}
DI void xcd_barrier_complete(unsigned* bar, unsigned x, unsigned& nloc, unsigned& nx) {
    const unsigned G = gridDim.x * gridDim.y * gridDim.z;
    unsigned sum, cnt, mine, sp = 0u;
    for (;;) {
        sum = 0u; cnt = 0u; mine = 0u;
#pragma unroll
        for (unsigned j = 0; j < 16; ++j) { const unsigned c = xb_ld(&bar[XB_XCNT(j)]); sum += c; cnt += (c > 0u) ? 1u : 0u; mine = (j == x) ? c : mine; }
        if (sum == G) break;
        __builtin_amdgcn_s_sleep(1);
        if ((++sp & 255u) == 0u) { if (xb_ld(&bar[XB_TMO])) break; if (sp > XB_SPIN_CAP) { atomicAdd(&bar[XB_TMO], 1u); break; } }
    }
    nloc = mine > 0u ? mine : 1u; nx = cnt > 0u ? cnt : 1u;
}
DI void xcd_barrier(const XcdBarrier& b) {
    asm volatile("s_waitcnt vmcnt(0)" ::: "memory");
    __syncthreads();
    if (threadIdx.x == 0) {
        unsigned* bar = b.bar;
        __builtin_amdgcn_s_waitcnt(0);
        unsigned nloc = b.st[0], nx = b.st[1];
        if (nloc == 0u) { xcd_barrier_complete(bar, b.x, nloc, nx); b.st[0] = nloc; b.st[1] = nx; }
        const unsigned old = xb_add(&bar[XB_XSUB(b.x)], 1u);
        const unsigned gen = old / nloc;
        if (old + 1u == (gen + 1u) * nloc) {
            __builtin_amdgcn_fence(__ATOMIC_RELEASE, "agent");
            asm volatile("s_waitcnt vmcnt(0)" ::: "memory");
            const unsigned og = xb_add(&bar[XB_TOP], 1u);
            const unsigned tg = og / nx;
            if (og + 1u == (tg + 1u) * nx) xb_add(&bar[XB_TOPGEN], 1u);
            else XB_SPIN(xb_ld(&bar[XB_TOPGEN]) == tg, bar);
            __builtin_amdgcn_fence(__ATOMIC_ACQUIRE, "agent");
            xb_add(&bar[XB_XGEN(b.x)], 1u);
            asm volatile("s_waitcnt vmcnt(0)" ::: "memory");
        } else {
            XB_SPIN(xb_ld(&bar[XB_XGEN(b.x)]) == gen, bar);
            __builtin_amdgcn_fence(__ATOMIC_ACQUIRE, "agent");
            asm volatile("s_waitcnt vmcnt(0)" ::: "memory");
        }
    }
    __syncthreads();
}

struct Frame {
    LAS unsigned char* lds;
    volatile LAS unsigned* MISC;
    gu32* ctl;
    int tid, lane, wave, vcu, G;
    const float *x, *mem, *norm_g, *w_in, *conv_w, *a_log, *dt_bias, *gdn_ng, *i_bias, *f_bias, *ml_ng, *mem_ng, *w_kv, *w_out, *fin_g;
    float* out;
    bf16 *XN, *WIN, *WOUT, *KV, *KM, *VT, *PROJ, *HALO;
    unsigned char* CHK;
    float* GATES;
};

DI int win_old_col(int n) {
    if (n < 2304) return n;
    if (n < 5376) return n + 12;
    if (n < NP) return n + 24;
    const int c = n - NP;
    if (c < 12) return 2304 + c;
    if (c < 24) return 5388 + (c - 12);
    return -1;
}
DI void p0_transpose_item(const float* W, int K, int Nold, bf16* WT, int nblk, int mode, LAS float* scr, int item, int lane) {
    const int kb = item / nblk, nb = item % nblk, k0 = 64 * kb, n0 = 32 * nb;
    const int nn = n0 + (lane & 31);
    const int oc = mode ? win_old_col(nn) : nn;
#pragma unroll 8
    for (int i = 0; i < 32; ++i) { const int kk = 2 * i + (lane >> 5); scr[kk * 33 + (lane & 31)] = oc >= 0 ? W[(size_t)(k0 + kk) * Nold + oc] : 0.f; }
    LDS_WAIT(); asm volatile("" ::: "memory");
    const int c = lane & 7;
#pragma unroll
    for (int j = 0; j < 4; ++j) { const int n = (lane >> 3) + 8 * j; const LAS float* s = scr + (8 * c) * 33 + n;
        v4u o; o.x = pk2(s[0 * 33], s[1 * 33]); o.y = pk2(s[2 * 33], s[3 * 33]); o.z = pk2(s[4 * 33], s[5 * 33]); o.w = pk2(s[6 * 33], s[7 * 33]);
        *(GAS v4u*)(WT + (size_t)(n0 + n) * K + k0 + 8 * c) = o; }
    LDS_WAIT(); asm volatile("" ::: "memory");
}
DI void rms_row_to_bf16(int lane, const float* xrow, const float* g, bf16* orow) {
    const GAS f32x4* xr = (const GAS f32x4*)xrow + lane; const GAS f32x4* gr = (const GAS f32x4*)g + lane;
    f32x4 v[4]; float s = 0.f;
#pragma unroll
    for (int j = 0; j < 4; ++j) { v[j] = xr[64 * j]; s += (v[j].x * v[j].x + v[j].y * v[j].y) + (v[j].z * v[j].z + v[j].w * v[j].w); }
    const float rstd = 1.f / sqrtf(wave_sum(s) * (1.f / DM) + EPS);
    GAS unsigned long long* o8 = (GAS unsigned long long*)orow + lane;
#pragma unroll
    for (int j = 0; j < 4; ++j) { const f32x4 gg = gr[64 * j];
        o8[64 * j] = (unsigned long long)pk2(v[j].x * rstd * gg.x, v[j].y * rstd * gg.y) | ((unsigned long long)pk2(v[j].z * rstd * gg.z, v[j].w * rstd * gg.w) << 32); }
}
DI void p0_prologue(Frame& F) {
    LAS float* scr = (LAS float*)(F.lds + RING_OFF + F.wave * 16384);
    const int gw = F.vcu * NWAVES + F.wave, NGW = F.G * NWAVES;
    constexpr int I_IN = (DM / 64) * (NG / 32), I_KV = (DM / 64) * (NKV / 32), I_OUT = (KOUT / 64) * (DM / 32);
    for (int it = gw; it < I_IN + I_KV + I_OUT; it += NGW) {
        int r = it;
        if (r < I_IN) { p0_transpose_item(F.w_in, DM, IN_COLS, F.WIN, NG / 32, 1, scr, r, F.lane); continue; } r -= I_IN;
        if (r < I_KV) { p0_transpose_item(F.w_kv, DM, NKV, F.WIN + (size_t)NG * DM, NKV / 32, 0, scr, r, F.lane); continue; } r -= I_KV;
        p0_transpose_item(F.w_out, KOUT, DM, F.WOUT, DM / 32, 0, scr, r, F.lane);
    }
    for (int m = gw; m < MTOK + MMEM; m += NGW) {
        if (m < MTOK) rms_row_to_bf16(F.lane, F.x + (size_t)m * DM, F.norm_g, F.XN + (size_t)m * DM);
        else rms_row_to_bf16(F.lane, F.mem + (size_t)(m - MTOK) * DM, F.mem_ng, F.XN + (size_t)m * DM);
    }
}

template <class ACol, class Epi>
DI void gemm_ref_tile(Frame& F, const bf16* A, int lda, const bf16* Bt, int ldb, int m0, int n0, int K, const ACol& acol, const Epi& E) {
    LAS float* As = (LAS float*)(F.lds + RING_OFF);
    LAS float* Bs = As + 16 * 132;
    const int tid = F.tid, tx = tid & 15, ty = tid >> 4;
    float acc[4][8];
#pragma unroll
    for (int r = 0; r < 4; ++r)
#pragma unroll
        for (int c = 0; c < 8; ++c) acc[r][c] = 0.f;
    const int lrow = (tid & 255) >> 1, lch = tid & 1;
    for (int k0 = 0; k0 < K; k0 += 16) {
        v4u v;
        if (tid < 256) v = *(const GAS v4u*)(A + (size_t)(m0 + lrow) * lda + acol(k0) + lch * 8);
        else v = *(const GAS v4u*)(Bt + (size_t)(n0 + lrow) * ldb + k0 + lch * 8);
        __syncthreads();
        LAS float* dst = (tid < 256 ? As : Bs) + (lch * 8) * 132 + lrow;
        dst[0 * 132] = bflo(v.x); dst[1 * 132] = bfhi(v.x); dst[2 * 132] = bflo(v.y); dst[3 * 132] = bfhi(v.y);
        dst[4 * 132] = bflo(v.z); dst[5 * 132] = bfhi(v.z); dst[6 * 132] = bflo(v.w); dst[7 * 132] = bfhi(v.w);
        __syncthreads();
#pragma unroll 4
        for (int k = 0; k < 16; ++k) {
            const f32x4 a = *(const LAS f32x4*)(As + k * 132 + ty * 4);
            const f32x4 b0 = *(const LAS f32x4*)(Bs + k * 132 + tx * 8), b1 = *(const LAS f32x4*)(Bs + k * 132 + tx * 8 + 4);
#pragma unroll
            for (int r = 0; r < 4; ++r) {
                acc[r][0] += a[r] * b0.x; acc[r][1] += a[r] * b0.y; acc[r][2] += a[r] * b0.z; acc[r][3] += a[r] * b0.w;
                acc[r][4] += a[r] * b1.x; acc[r][5] += a[r] * b1.y; acc[r][6] += a[r] * b1.z; acc[r][7] += a[r] * b1.w; }
        }
    }
#pragma unroll
    for (int r = 0; r < 4; ++r) E(m0 + ty * 4 + r, n0 + tx * 8, acc[r]);
    __syncthreads();
}
struct AColId { DI int operator()(int k) const { return k; } };
struct AColMix { DI int operator()(int k) const { return k < 768 ? C_GV + k : (k < 1536 ? C_MV + (k - 768) : C_XQ + (k - 1536)); } };

DI float gate_transform(const Frame& F, int c, float v) {
    const int kind = c / 6, h = c - kind * 6;
    if (kind == 0) return -__expf(F.a_log[h]) * softplusf_(v + F.dt_bias[h]);
    if (kind == 1) return sigmoidf_(v);
    if (kind == 2) return v + F.i_bias[h];
    return -softplusf_(-(v + F.f_bias[h]));
}
struct EpiProjRef {
    const Frame* F;
    DI void operator()(int m, int n, const float (&v)[8]) const {
        if (m < MTOK) {
            if (n < NP) { v4u o; o.x = pk2(v[0], v[1]); o.y = pk2(v[2], v[3]); o.z = pk2(v[4], v[5]); o.w = pk2(v[6], v[7]); *(GAS v4u*)(F->PROJ + (size_t)m * NP + n) = o; }
            else {
#pragma unroll
                for (int j = 0; j < 8; ++j) { const int c = n - NP + j; if (c < 24) F->GATES[(size_t)m * 32 + c] = v[j]; }
            }
        } else {
            v4u o; o.x = pk2(v[0], v[1]); o.y = pk2(v[2], v[3]); o.z = pk2(v[4], v[5]); o.w = pk2(v[6], v[7]);
            *(GAS v4u*)(F->KV + (size_t)(m - MTOK) * NKV + (n - NG)) = o;
        }
    }
};
struct EpiOutRef {
    const Frame* F;
    DI void operator()(int m, int n, const float (&v)[8]) const {
        const GAS f32x4* xr = (const GAS f32x4*)(F->x + (size_t)m * DM + n);
        const f32x4 x0 = xr[0], x1 = xr[1];
        GAS f32x4* o = (GAS f32x4*)(F->out + (size_t)m * DM + n);
        o[0] = (f32x4){x0.x + v[0], x0.y + v[1], x0.z + v[2], x0.w + v[3]};
        o[1] = (f32x4){x1.x + v[4], x1.y + v[5], x1.z + v[6], x1.w + v[7]};
    }
};
DI void p1_gemm_in_ref(Frame& F) {
    constexpr int T1 = (MTOK / 128) * (NG / 128), T2 = (MMEM / 128) * (NKV / 128);
    EpiProjRef E{&F};
    for (int L = F.vcu; L < T1 + T2; L += F.G) {
        int m0, n0;
        if (L < T1) { m0 = (L / (NG / 128)) * 128; n0 = (L % (NG / 128)) * 128; }
        else { const int r = L - T1; m0 = MTOK + (r / (NKV / 128)) * 128; n0 = NG + (r % (NKV / 128)) * 128; }
        gemm_ref_tile(F, F.XN, DM, F.WIN, DM, m0, n0, DM, AColId{}, E);
    }
}
DI void p3_gemm_out_ref(Frame& F) {
    constexpr int T1 = (MTOK / 128) * (DM / 128);
    EpiOutRef E{&F};
    for (int L = F.vcu; L < T1; L += F.G) {
        const int m0 = (L / (DM / 128)) * 128, n0 = (L % (DM / 128)) * 128;
        gemm_ref_tile(F, F.PROJ, NP, F.WOUT, KOUT, m0, n0, KOUT, AColMix{}, E);
    }
}
DI void p4_final_norm(Frame& F) {
    const int gw = F.vcu * NWAVES + F.wave, NGW = F.G * NWAVES;
    for (int m = gw; m < MTOK; m += NGW) {
        GAS f32x4* yr = (GAS f32x4*)(F.out + (size_t)m * DM) + F.lane; const GAS f32x4* gr = (const GAS f32x4*)F.fin_g + F.lane;
        f32x4 v[4]; float s = 0.f;
#pragma unroll
        for (int j = 0; j < 4; ++j) { v[j] = yr[64 * j]; s += (v[j].x * v[j].x + v[j].y * v[j].y) + (v[j].z * v[j].z + v[j].w * v[j].w); }
        const float rstd = 1.f / sqrtf(wave_sum(s) * (1.f / DM) + EPS);
#pragma unroll
        for (int j = 0; j < 4; ++j) { const f32x4 gg = gr[64 * j]; yr[64 * j] = (f32x4){v[j].x * rstd * gg.x, v[j].y * rstd * gg.y, v[j].z * rstd * gg.z, v[j].w * rstd * gg.w}; }
    }
}

namespace pg8 {
#define PG8_LAS __attribute__((address_space(3)))
typedef unsigned short bf16_t;
typedef short bf16x8 __attribute__((ext_vector_type(8)));
typedef float f32x4 __attribute__((ext_vector_type(4)));
typedef unsigned u32x4 __attribute__((ext_vector_type(4)));
constexpr int BM = 256, BK = 64, HALF = 128, HTB = HALF * BK * 2, STAGE_BYTES = 8 * HTB, NXCD = 8, WGM = 8;
__host__ __device__ __forceinline__ int lds_byte(int r, int c) { const int st = (r >> 4) * 2 + (c >> 5), rr = r & 15, cc = c & 31, ob = rr * 64 + cc * 2; return st * 1024 + (ob ^ (((ob >> 9) & 1) << 5)); }
__host__ __device__ __forceinline__ void stage_rc(int b, int& R, int& C) { const int st = b / 1024, sb = b % 1024, swz = sb ^ (((sb >> 9) & 1) << 5); R = (st >> 1) * 16 + swz / 64; C = (st & 1) * 32 + (swz % 64) / 2; }
__host__ __device__ __forceinline__ int perm32(int rho) { const int n = rho >> 4, i = rho & 15; return 8 * (i >> 2) + 4 * n + (i & 3); }
struct Unit { int pm, pn; };
struct Gemm { const bf16_t* A; const bf16_t* Bt; int K, lda, ldb; };
__host__ __device__ __forceinline__ void tile_of(int L, int nM, int nN, Unit& u) {
    const int nwg = nM * nN; int wgid = L;
    { const int q = nwg / NXCD, r = nwg % NXCD, xcd = wgid % NXCD, off = wgid / NXCD; wgid = (xcd < r ? xcd * (q + 1) : r * (q + 1) + (xcd - r) * q) + off; }
    const int nig = WGM * nN, gid = wgid / nig, fm = gid * WGM, gsz = (nM - fm) < WGM ? (nM - fm) : WGM;
    u.pm = fm + ((wgid % nig) % gsz); u.pn = (wgid % nig) / gsz;
}
struct StaticOrder {
    int nM, nN, nwg, G, c;
    __host__ __device__ void init(int M, int N, int G_, int c_) { nM = M / BM; nN = N / BM; nwg = nM * nN; G = G_; c = c_; }
    __host__ __device__ bool next(int i, Unit& u) const { const long L = (long)i * G + c; if (L >= nwg) return false; tile_of((int)L, nM, nN, u); return true; }
    __device__ __forceinline__ void a_ready(const Unit&) const {}
    __device__ __forceinline__ void done(const Unit&) const {}
};
__device__ __forceinline__ unsigned cvt_pk_bf16(float lo, float hi) { unsigned r; asm volatile("v_cvt_pk_bf16_f32 %0, %1, %2" : "=v"(r) : "v"(lo), "v"(hi)); return r; }
struct AMapId { __device__ __forceinline__ size_t operator()(int t) const { return (size_t)t * (BK * 2); } };

template <class Epi, class Sched, class AMap, bool ALIGN_EPI>
__device__ __forceinline__ void gemm_phase(PG8_LAS unsigned char* lds, const Gemm g, const Sched& S, const Epi& E, const AMap& AM) {
    const int tid = threadIdx.x, wid = __builtin_amdgcn_readfirstlane(tid >> 6), lane = tid & 63, wr = wid >> 2, wc = wid & 3, fr = lane & 15, fq = lane >> 4;
    const int K = g.K, nt = K / BK;
    unsigned voffA[2], voffB[2];
#pragma unroll
    for (int i = 0; i < 2; ++i) { int R, C; stage_rc(tid * 16 + i * 8192, R, C); const int Rb = Epi::PERM ? ((R & ~31) + perm32(R & 31)) : R;
        voffA[i] = (unsigned)(R * g.lda + C) * 2u; voffB[i] = (unsigned)(Rb * g.ldb + C) * 2u; }
    const size_t kstep = (size_t)(BK * 2);
    const size_t hstepA = (size_t)HALF * g.lda * 2, hstepB = (size_t)HALF * g.ldb * 2;
    const size_t tstepA = 2 * hstepA, tstepB = 2 * hstepB;
    const unsigned ldsw = (unsigned)wid * 1024u;
    const int aoff = lds_byte(wr * 64 + fr, fq * 8), boff = lds_byte(wc * 32 + fr, fq * 8);
#define PG8_SA(b, h) (((b) * 2 + (h)) * HTB)
#define PG8_SB(b, h) ((4 + (b) * 2 + (h)) * HTB)
#define PG8_STAGE(bufoff, gbase, voff) do { _Pragma("unroll") for (int _i = 0; _i < 2; ++_i) \
        __builtin_amdgcn_global_load_lds((const unsigned*)((const char*)(gbase) + (voff)[_i]), (PG8_LAS unsigned*)(lds + (bufoff) + ldsw + _i * 8192), 16, 0, 0); } while (0)
#define PG8_LDA(dst, b, h) do { _Pragma("unroll") for (int m = 0; m < 4; ++m) _Pragma("unroll") for (int k = 0; k < 2; ++k) dst[m][k] = *(const PG8_LAS bf16x8*)(lds + PG8_SA(b, h) + aoff + m * 2048 + k * 1024); } while (0)
#define PG8_LDB(dst, b, h) do { _Pragma("unroll") for (int n = 0; n < 2; ++n) _Pragma("unroll") for (int k = 0; k < 2; ++k) dst[n][k] = *(const PG8_LAS bf16x8*)(lds + PG8_SB(b, h) + boff + n * 2048 + k * 1024); } while (0)
#define PG8_MMA(ai, bj, At, Bt) do { __builtin_amdgcn_s_setprio(1); _Pragma("unroll") for (int m = 0; m < 4; ++m) _Pragma("unroll") for (int n = 0; n < 2; ++n) _Pragma("unroll") for (int k = 0; k < 2; ++k) \
        acc[ai][bj][m][n] = __builtin_amdgcn_mfma_f32_16x16x32_bf16(Bt[n][k], At[m][k], acc[ai][bj][m][n], 0, 0, 0); __builtin_amdgcn_s_setprio(0); } while (0)
#define PG8_WAIT_V(n) asm volatile("s_waitcnt vmcnt(" #n ")" ::: "memory")
#define PG8_WAIT_L(n) asm volatile("s_waitcnt lgkmcnt(" #n ")" ::: "memory")
#define PG8_BAR __builtin_amdgcn_s_barrier()
#define PG8_SCHED __builtin_amdgcn_sched_barrier(0)
    Unit cur, nxt; int ui = 0;
    if (!S.next(0, cur)) return;
    f32x4 acc[2][2][4][2];
#pragma unroll
    for (int a = 0; a < 2; ++a)
#pragma unroll
        for (int b = 0; b < 2; ++b)
#pragma unroll
            for (int m = 0; m < 4; ++m)
#pragma unroll
                for (int n = 0; n < 2; ++n) acc[a][b][m][n] = (f32x4){0.f, 0.f, 0.f, 0.f};
    bf16x8 At[4][2], B0[2][2], B1[2][2];
    const char* cA = (const char*)g.A + (size_t)cur.pm * tstepA; const char* cB = (const char*)g.Bt + (size_t)cur.pn * tstepB;
    S.a_ready(cur);
    PG8_STAGE(PG8_SB(0, 0), cB, voffB); PG8_STAGE(PG8_SB(0, 1), cB + hstepB, voffB); PG8_STAGE(PG8_SA(0, 0), cA + AM(0), voffA); PG8_STAGE(PG8_SA(0, 1), cA + AM(0) + hstepA, voffA);
    if (wr == 1) PG8_BAR;
    PG8_WAIT_V(2); PG8_BAR;
    PG8_STAGE(PG8_SB(1, 0), cB + kstep, voffB); PG8_STAGE(PG8_SA(1, 0), cA + AM(1), voffA); PG8_STAGE(PG8_SB(1, 1), cB + hstepB + kstep, voffB);
    PG8_WAIT_V(6); PG8_BAR;
    for (;;) {
        const bool has_next = S.next(ui + 1, nxt);
        const char* nA = has_next ? (const char*)g.A + (size_t)nxt.pm * tstepA : cA; const char* nB = has_next ? (const char*)g.Bt + (size_t)nxt.pn * tstepB : cB;
        for (int t = 0; t < nt; t += 2) {
            const bool last = (t == nt - 2);
            const char* a1 = cA + AM(t + 1);
            const char* a2 = last ? nA + AM(0) : cA + AM(t + 2); const char* b2 = last ? nB : cB + (size_t)(t + 2) * kstep;
            const char* a3 = last ? nA + AM(1) : cA + AM(t + 3); const char* b3 = b2 + kstep;
            if (last && has_next) S.a_ready(nxt);
            PG8_LDB(B0, 0, 0); PG8_LDB(B1, 0, 1); PG8_SCHED; PG8_LDA(At, 0, 0); PG8_STAGE(PG8_SA(1, 1), a1 + hstepA, voffA);
            PG8_WAIT_V(8); PG8_WAIT_L(0); PG8_BAR; PG8_MMA(0, 0, At, B0); PG8_MMA(0, 1, At, B1); PG8_BAR; PG8_SCHED;
            PG8_LDA(At, 0, 1); PG8_STAGE(PG8_SB(0, 0), b2, voffB); PG8_STAGE(PG8_SB(0, 1), b2 + hstepB, voffB); PG8_STAGE(PG8_SA(0, 0), a2, voffA);
            PG8_WAIT_V(8); PG8_WAIT_L(0); PG8_BAR; PG8_MMA(1, 0, At, B0); PG8_MMA(1, 1, At, B1); PG8_BAR; PG8_SCHED;
            PG8_LDB(B0, 1, 0); PG8_LDB(B1, 1, 1); PG8_SCHED; PG8_LDA(At, 1, 0); PG8_STAGE(PG8_SA(0, 1), a2 + hstepA, voffA);
            PG8_WAIT_V(8); PG8_WAIT_L(0); PG8_BAR; PG8_MMA(0, 0, At, B0); PG8_MMA(0, 1, At, B1); PG8_BAR; PG8_SCHED;
            PG8_LDA(At, 1, 1); PG8_STAGE(PG8_SB(1, 0), b3, voffB); PG8_STAGE(PG8_SB(1, 1), b3 + hstepB, voffB); PG8_STAGE(PG8_SA(1, 0), a3, voffA);
            PG8_WAIT_V(8); PG8_WAIT_L(0); PG8_BAR; PG8_MMA(1, 0, At, B0); PG8_MMA(1, 1, At, B1); PG8_BAR; PG8_SCHED;
        }
        if constexpr (ALIGN_EPI) { if (wr == 0) PG8_BAR; }
        if constexpr (!Epi::AFTER_DRAIN) { E(acc, cur, wr, wc, fr, fq); S.done(cur); }
        if (!has_next) break;
#pragma unroll
        for (int a = 0; a < 2; ++a)
#pragma unroll
            for (int b = 0; b < 2; ++b)
#pragma unroll
                for (int m = 0; m < 4; ++m)
#pragma unroll
                    for (int n = 0; n < 2; ++n) acc[a][b][m][n] = (f32x4){0.f, 0.f, 0.f, 0.f};
        cur = nxt; cA = nA; cB = nB; ++ui;
        if constexpr (ALIGN_EPI) { if (wr == 1) PG8_BAR; }
    }
    PG8_WAIT_V(0);
    if constexpr (!ALIGN_EPI) { if (wr == 0) PG8_BAR; }
    PG8_BAR;
    if constexpr (Epi::AFTER_DRAIN) { E.fused(acc, cur, wr, wc, fr, fq, lds, wid, lane); S.done(cur); }
#undef PG8_SA
#undef PG8_SB
#undef PG8_STAGE
#undef PG8_LDA
#undef PG8_LDB
#undef PG8_MMA
#undef PG8_WAIT_V
#undef PG8_WAIT_L
#undef PG8_BAR
#undef PG8_SCHED
}
}

constexpr int ZT_WIN = (MTOK + MMEM) / 256, ZT_MEM = MTOK / 256, ZT_WK = ZT_WIN + NG / 256, ZT_WV = ZT_WK + 2;
struct OrderIn {
    int G, c;
    __device__ __forceinline__ bool next(int i, pg8::Unit& u) const {
        const long L = (long)i * G + c;
        if (L < 4096) { pg8::tile_of((int)L, MTOK / 256, NG / 256, u); u.pn += ZT_WIN; return true; }
        const int r = (int)L - 4096; if (r >= 32) return false;
        if (r < 16) { u.pm = ZT_MEM + (r >> 1); u.pn = ZT_WK + (r & 1); } else { u.pm = ZT_WV + ((r - 16) >> 3); u.pn = ZT_MEM + ((r - 16) & 7); }
        return true;
    }
    __device__ __forceinline__ void a_ready(const pg8::Unit&) const {}
    __device__ __forceinline__ void done(const pg8::Unit&) const {}
};
struct EpiProj {
    static constexpr bool PERM = true, AFTER_DRAIN = false;
    const Frame* F;
    __device__ __forceinline__ void operator()(const pg8::f32x4 (&acc)[2][2][4][2], const pg8::Unit& u, int wr, int wc, int fr, int fq) const {
        const int row0 = u.pm * 256 + wr * 64 + fr, colt = wc * 32 + 8 * fq;
        if (u.pm < ZT_MEM && u.pn == ZT_WIN + NP / 256) {
            if (wc == 0 && fq < 3) {
#pragma unroll
                for (int ai = 0; ai < 2; ++ai)
#pragma unroll
                    for (int m = 0; m < 4; ++m) { float* gp = F->GATES + (size_t)(row0 + ai * 128 + m * 16) * 32 + 8 * fq;
                        *(pg8::f32x4*)gp = acc[ai][0][m][0]; *(pg8::f32x4*)(gp + 4) = acc[ai][0][m][1]; }
            }
            return;
        }
        bf16* base; int ldc;
        if (u.pm < ZT_MEM && u.pn < ZT_WIN + 9 && fr >= 13) {
#pragma unroll
            for (int ai = 0; ai < 2; ++ai) { const int rowg = row0 + ai * 128 + 48;
                bf16* hp = F->HALO + ((size_t)(rowg >> 6) * 3 + (fr - 13)) * 2304 + (size_t)(u.pn - ZT_WIN) * 256 + colt;
#pragma unroll
                for (int bj = 0; bj < 2; ++bj) { const pg8::f32x4 v0 = acc[ai][bj][3][0], v1 = acc[ai][bj][3][1];
                    v4u w; w.x = pg8::cvt_pk_bf16(v0[0], v0[1]); w.y = pg8::cvt_pk_bf16(v0[2], v0[3]); w.z = pg8::cvt_pk_bf16(v1[0], v1[1]); w.w = pg8::cvt_pk_bf16(v1[2], v1[3]);
                    *(v4u*)(hp + bj * 128) = w; } }
        }
        if (u.pm < ZT_MEM) { base = F->PROJ + (size_t)(u.pn - ZT_WIN) * 256; ldc = NP; }
        else if (u.pm < ZT_WIN) { base = F->KM - (size_t)MTOK * 512 + (size_t)(u.pn - ZT_WK) * 256; ldc = 512; }
        else { base = F->VT - (size_t)(ZT_WV * 256) * MMEM + (size_t)(u.pn - ZT_MEM) * 256; ldc = MMEM; }
#pragma unroll
        for (int ai = 0; ai < 2; ++ai)
#pragma unroll
            for (int m = 0; m < 4; ++m) { bf16* rowp = base + (size_t)(row0 + ai * 128 + m * 16) * ldc + colt;
#pragma unroll
                for (int bj = 0; bj < 2; ++bj) { const pg8::f32x4 v0 = acc[ai][bj][m][0], v1 = acc[ai][bj][m][1];
                    v4u w; w.x = pg8::cvt_pk_bf16(v0[0], v0[1]); w.y = pg8::cvt_pk_bf16(v0[2], v0[3]); w.z = pg8::cvt_pk_bf16(v1[0], v1[1]); w.w = pg8::cvt_pk_bf16(v1[2], v1[3]);
                    *(v4u*)(rowp + bj * 128) = w; } }
    }
};
struct AMapMix { __device__ __forceinline__ size_t operator()(int t) const { const int k = t * 64; return (size_t)(k < 768 ? C_GV + k : (k < 1536 ? C_MV + (k - 768) : C_XQ + (k - 1536))) * 2; } };
struct EpiOut {
    static constexpr bool PERM = false, AFTER_DRAIN = false;
    const float* x; float* out;
    __device__ __forceinline__ void operator()(const pg8::f32x4 (&acc)[2][2][4][2], const pg8::Unit& u, int wr, int wc, int fr, int fq) const {
        const int row0 = u.pm * 256 + wr * 64 + fr, col0 = u.pn * 256 + wc * 32 + 4 * fq;
#pragma unroll
        for (int ai = 0; ai < 2; ++ai)
#pragma unroll
            for (int m = 0; m < 4; ++m) { const size_t off = (size_t)(row0 + ai * 128 + m * 16) * DM + col0;
#pragma unroll
                for (int bj = 0; bj < 2; ++bj)
#pragma unroll
                    for (int n = 0; n < 2; ++n) { const pg8::f32x4 xv = *(const pg8::f32x4*)(x + off + bj * 128 + n * 16); *(pg8::f32x4*)(out + off + bj * 128 + n * 16) = xv + acc[ai][bj][m][n]; } }
    }
};
DI void p1_gemm_in(Frame& F) {
    pg8::Gemm g{F.XN, F.XN, DM, DM, DM}; OrderIn S{F.G, (int)blockIdx.x}; EpiProj E{&F};
    pg8::gemm_phase<EpiProj, OrderIn, pg8::AMapId, true>(F.lds + RING_OFF, g, S, E, pg8::AMapId{});
}
DI void p3_gemm_out(Frame& F) {
    pg8::Gemm g{F.PROJ, F.WOUT, KOUT, NP, KOUT}; pg8::StaticOrder S; S.init(MTOK, DM, F.G, (int)blockIdx.x); EpiOut E{F.x, F.out};
    pg8::gemm_phase<EpiOut, pg8::StaticOrder, AMapMix, true>(F.lds + RING_OFF, g, S, E, AMapMix{});
}

DI void gdn_ref_item(Frame& F, int item) {
    const int b = item / 6, h = item % 6, tid = F.tid, lane = F.lane, wave = F.wave;
    LAS float* QKV = (LAS float*)(F.lds + RING_OFF);
    LAS float* OB = (LAS float*)(F.lds + RING_OFF + 98304);
    LAS bf16* HALOV = (LAS bf16*)(F.lds + XTRA_OFF);
    LAS float* AT = (LAS float*)(F.lds + XTRA_OFF + 768);
    LAS float* BT = AT + 64;
    float S[128];
#pragma unroll
    for (int d = 0; d < 128; ++d) S[d] = 0.f;
    for (int c = 0; c < NCH; ++c) {
        const int m0 = b * SEQ + c * CH;
#pragma unroll 2
        for (int i = 0; i < 48; ++i) {
            const int idx = tid + NTHR * i, t = idx / 384, cc = idx - t * 384, seg = cc >> 7, d = cc & 127;
            QKV[t * 384 + cc] = bf2f(F.PROJ[(size_t)(m0 + t) * NP + seg * 768 + h * 128 + d]);
        }
        if (tid < 64) { AT[tid] = __expf(gate_transform(F, h, F.GATES[(size_t)(m0 + tid) * 32 + h])); BT[tid] = gate_transform(F, 6 + h, F.GATES[(size_t)(m0 + tid) * 32 + 6 + h]); }
        __syncthreads();
        if (tid < 128) {
            const int e = tid;
#pragma unroll 1
            for (int t = 0; t < CH; ++t) {
                const LAS float* q = QKV + t * 384; const LAS float* k = q + 128;
                const float a = AT[t], be = BT[t], v = q[256 + e];
                float r = 0.f;
#pragma unroll
                for (int db = 0; db < 128; db += 16) {
#pragma unroll
                    for (int d = 0; d < 16; ++d) r += k[db + d] * S[db + d];
                    asm volatile("" ::: "memory");
                }
                const float vn = be * (v - a * r);
                float o = 0.f;
#pragma unroll
                for (int db = 0; db < 128; db += 16) {
#pragma unroll
                    for (int d = 0; d < 16; ++d) { S[db + d] = a * S[db + d] + k[db + d] * vn; o += q[db + d] * S[db + d]; }
                    asm volatile("" ::: "memory");
                }
                OB[t * 128 + e] = o;
            }
        }
        __syncthreads();
#pragma unroll 1
        for (int i = 0; i < 8; ++i) {
            const int t = wave + 8 * i;
            const float o0 = OB[t * 128 + lane], o1 = OB[t * 128 + 64 + lane];
            const float rstd = 1.f / sqrtf(wave_sum(o0 * o0 + o1 * o1) * (1.f / 128.f) + EPS);
            const size_t row = (size_t)(m0 + t) * NP;
            const float z0 = bf2f(F.PROJ[row + C_GZ + h * 128 + lane]), z1 = bf2f(F.PROJ[row + C_GZ + h * 128 + 64 + lane]);
            F.PROJ[row + C_GV + h * 128 + lane] = (bf16)f2bf(o0 * rstd * F.gdn_ng[lane] * siluf_(z0));
            F.PROJ[row + C_GV + h * 128 + 64 + lane] = (bf16)f2bf(o1 * rstd * F.gdn_ng[64 + lane] * siluf_(z1));
        }
        __syncthreads();
    }
}
DI void mlstm_ref_item(Frame& F, int item) {
    const int b = item / 6, h = item % 6, tid = F.tid, lane = F.lane, wave = F.wave;
    LAS float* QKV = (LAS float*)(F.lds + RING_OFF);
    LAS float* NUM = (LAS float*)(F.lds + RING_OFF + 98304);
    LAS float* FT = (LAS float*)(F.lds + XTRA_OFF);
    LAS float* IT = FT + 64;
    LAS float* DEN = IT + 64;
    float C[128];
#pragma unroll
    for (int d = 0; d < 128; ++d) C[d] = 0.f;
    float n0 = 0.f, n1 = 0.f;
    for (int c = 0; c < NCH; ++c) {
        const int m0 = b * SEQ + c * CH;
#pragma unroll 2
        for (int i = 0; i < 48; ++i) {
            const int idx = tid + NTHR * i, t = idx / 384, cc = idx - t * 384, seg = cc >> 7, d = cc & 127;
            float v = bf2f(F.PROJ[(size_t)(m0 + t) * NP + C_MQ + seg * 768 + h * 128 + d]);
            if (seg == 1) v *= RSQRT_HD;
            QKV[t * 384 + cc] = v;
        }
        if (tid < 64) { FT[tid] = __expf(gate_transform(F, 18 + h, F.GATES[(size_t)(m0 + tid) * 32 + 18 + h])); IT[tid] = __expf(gate_transform(F, 12 + h, F.GATES[(size_t)(m0 + tid) * 32 + 12 + h])); }
        __syncthreads();
        if (tid < 128) {
            const int e = tid;
#pragma unroll 1
            for (int t = 0; t < CH; ++t) {
                const LAS float* q = QKV + t * 384; const LAS float* k = q + 128;
                const float f = FT[t], iv = IT[t] * q[256 + e];
                float num = 0.f;
#pragma unroll
                for (int db = 0; db < 128; db += 16) {
#pragma unroll
                    for (int d = 0; d < 16; ++d) { C[db + d] = f * C[db + d] + iv * k[db + d]; num += q[db + d] * C[db + d]; }
                    asm volatile("" ::: "memory");
                }
                NUM[t * 128 + e] = num;
            }
        } else if (tid < 192) {
#pragma unroll 1
            for (int t = 0; t < CH; ++t) {
                const LAS float* q = QKV + t * 384; const LAS float* k = q + 128;
                const float f = FT[t], ig = IT[t];
                n0 = f * n0 + ig * k[lane]; n1 = f * n1 + ig * k[lane + 64];
                const float den = wave_sum(q[lane] * n0 + q[lane + 64] * n1);
                if (lane == 0) DEN[t] = den;
            }
        }
        __syncthreads();
#pragma unroll 1
        for (int i = 0; i < 8; ++i) {
            const int t = wave + 8 * i;
            const size_t row = (size_t)(m0 + t) * NP;
            const float dn = 1.f / fmaxf(fabsf(DEN[t]), 1.f);
            const float g0 = sigmoidf_(bf2f(F.PROJ[row + C_MO + h * 128 + lane])), g1 = sigmoidf_(bf2f(F.PROJ[row + C_MO + h * 128 + 64 + lane]));
            const float h0 = NUM[t * 128 + lane] * dn * g0, h1 = NUM[t * 128 + 64 + lane] * dn * g1;
            const float rstd = 1.f / sqrtf(wave_sum(h0 * h0 + h1 * h1) * (1.f / 128.f) + EPS);
            const float z0 = bf2f(F.PROJ[row + C_MZ + h * 128 + lane]), z1 = bf2f(F.PROJ[row + C_MZ + h * 128 + 64 + lane]);
            F.PROJ[row + C_MV + h * 128 + lane] = (bf16)f2bf(h0 * rstd * F.ml_ng[h * 128 + lane] * siluf_(z0));
            F.PROJ[row + C_MV + h * 128 + 64 + lane] = (bf16)f2bf(h1 * rstd * F.ml_ng[h * 128 + 64 + lane] * siluf_(z1));
        }
        __syncthreads();
    }
}
typedef short bf16x8 __attribute__((ext_vector_type(8)));
typedef __bf16 bf2_t __attribute__((ext_vector_type(2)));
typedef float f2_t __attribute__((ext_vector_type(2)));
DI unsigned cvt_pk_bf16(float lo, float hi) { return __builtin_bit_cast(unsigned, __builtin_convertvector((f2_t){lo, hi}, bf2_t)); }
DI unsigned cvt_pk_bf16_asm(float lo, float hi) { unsigned r; asm volatile("v_cvt_pk_bf16_f32 %0, %1, %2" : "=v"(r) : "v"(lo), "v"(hi)); return r; }
DI bf16x8 pack8_asm(const f32x4 a, const f32x4 b) { v4u p; p.x = cvt_pk_bf16_asm(a[0], a[1]); p.y = cvt_pk_bf16_asm(a[2], a[3]); p.z = cvt_pk_bf16_asm(b[0], b[1]); p.w = cvt_pk_bf16_asm(b[2], b[3]); return __builtin_bit_cast(bf16x8, p); }
DI bf16x8 pack8(const f32x4 a, const f32x4 b) { v4u p; p.x = cvt_pk_bf16(a[0], a[1]); p.y = cvt_pk_bf16(a[2], a[3]); p.z = cvt_pk_bf16(b[0], b[1]); p.w = cvt_pk_bf16(b[2], b[3]); return __builtin_bit_cast(bf16x8, p); }
#define MFMA16(a, b, c) __builtin_amdgcn_mfma_f32_16x16x32_bf16((a), (b), (c), 0, 0, 0)
DI void xattn_item(Frame& F, int item) {
    const int tt = item & 15, h = (item >> 4) & 3, b = item >> 6, tid = F.tid, lane = F.lane, wave = F.wave;
    const int lr = lane & 15, g = lane >> 4;
    LAS unsigned char* Kimg = F.lds + RING_OFF;
    LAS unsigned char* Vimg = F.lds + RING_OFF + 65536;
    __syncthreads();
#pragma unroll 2
    for (int i = 0; i < 8; ++i) {
        const int idx = tid + NTHR * i;
        { const int r = idx >> 4, ch = idx & 15;
          const v4u v = *(const GAS v4u*)(F.KM + (size_t)(b * NMEM + r) * 512 + h * 128 + ch * 8);
          *(LAS v4u*)(Kimg + r * 256 + ((ch ^ (r & 15)) << 4)) = v; }
        { const int r = idx >> 5, ch = idx & 31;
          const v4u v = *(const GAS v4u*)(F.VT + (size_t)(h * 128 + r) * MMEM + b * NMEM + ch * 8);
          *(LAS v4u*)(Vimg + r * 512 + ((ch ^ (r & 15)) << 4)) = v; }
    }
    __syncthreads();
#pragma unroll 1
    for (int p = 0; p < 2; ++p) {
        const int t0 = tt * 256 + wave * 32 + p * 16;
        const size_t row = (size_t)(b * SEQ + t0 + lr) * NP;
        bf16x8 qf[4];
#pragma unroll
        for (int ks = 0; ks < 4; ++ks) qf[ks] = *(const GAS bf16x8*)(F.PROJ + row + C_XQ + h * 128 + 32 * ks + 8 * g);
        f32x4 st[16];
#pragma unroll
        for (int mt = 0; mt < 16; ++mt) {
            const int j = 32 * (mt >> 1) + 8 * (lr >> 2) + 4 * (mt & 1) + (lr & 3);
            f32x4 acc = {0.f, 0.f, 0.f, 0.f};
#pragma unroll
            for (int ks = 0; ks < 4; ++ks) {
                const bf16x8 a = *(const LAS bf16x8*)(Kimg + j * 256 + (((4 * ks + g) ^ (j & 15)) << 4));
                acc = MFMA16(a, qf[ks], acc);
            }
            st[mt] = acc;
        }
        float mx = -3.0e38f;
#pragma unroll
        for (int mt = 0; mt < 16; ++mt) mx = fmaxf(mx, fmaxf(fmaxf(st[mt][0], st[mt][1]), fmaxf(st[mt][2], st[mt][3])));
        mx = fmaxf(mx, __shfl_xor(mx, 16)); mx = fmaxf(mx, __shfl_xor(mx, 32));
        float l = 0.f;
#pragma unroll
        for (int mt = 0; mt < 16; ++mt)
#pragma unroll
            for (int r = 0; r < 4; ++r) { const float pv = __expf((st[mt][r] - mx) * RSQRT_HD); st[mt][r] = pv; l += pv; }
        l += __shfl_xor(l, 16); l += __shfl_xor(l, 32);
        const float il = 1.f / l;
        bf16x8 pb[8];
#pragma unroll
        for (int ks = 0; ks < 8; ++ks) pb[ks] = pack8_asm(st[2 * ks], st[2 * ks + 1]);
#pragma unroll
        for (int dt = 0; dt < 8; ++dt) {
            const int d = 16 * dt + lr;
            f32x4 o = {0.f, 0.f, 0.f, 0.f};
#pragma unroll
            for (int ks = 0; ks < 8; ++ks) {
                const bf16x8 a = *(const LAS bf16x8*)(Vimg + d * 512 + (((4 * ks + g) ^ (d & 15)) << 4));
                o = MFMA16(a, pb[ks], o);
            }
            const int dc = h * 128 + 16 * dt + 4 * g;
            const v2u zz = *(const GAS v2u*)(F.PROJ + row + C_XZ + dc);
            v2u w; w.x = pk2(o[0] * il * siluf_(bflo(zz.x)), o[1] * il * siluf_(bfhi(zz.x))); w.y = pk2(o[2] * il * siluf_(bflo(zz.y)), o[3] * il * siluf_(bfhi(zz.y)));
            *(GAS v2u*)(F.PROJ + row + C_XQ + dc) = w;
        }
    }
}
typedef short s16x4 __attribute__((ext_vector_type(4)));
DI unsigned img_off(int row, int ch) { return 256u * (unsigned)row + 16u * (unsigned)(ch ^ (((row & 3) << 2) | ((row >> 2) & 3))); }
DI bf16x8 row_frag(const LAS unsigned char* img, int row, int ks, int g) { return *(const LAS bf16x8*)(img + img_off(row, 4 * ks + g)); }
DI bf16x8 tr_frag(LAS unsigned char* img, int row0, int col0, int lane) {
    const int i = lane & 15, g = lane >> 4, r0 = row0 + 8 * g + (i >> 2), c = col0 + 4 * (i & 3);
    const s16x4 a = __builtin_amdgcn_ds_read_tr16_b64_v4i16((LAS s16x4*)(img + img_off(r0, c >> 3) + (c & 4) * 2));
    const s16x4 b = __builtin_amdgcn_ds_read_tr16_b64_v4i16((LAS s16x4*)(img + img_off(r0 + 4, c >> 3) + (c & 4) * 2));
    return (bf16x8){a[0], a[1], a[2], a[3], b[0], b[1], b[2], b[3]};
}
DI float wave_incl_sum(float x, int lane) {
#pragma unroll
    for (int o = 1; o < 64; o <<= 1) { const float y = __shfl_up(x, o); if (lane >= o) x += y; }
    return x;
}
DI float wave_incl_max(float x, int lane) {
#pragma unroll
    for (int o = 1; o < 64; o <<= 1) { const float y = __shfl_up(x, o); if (lane >= o) x = fmaxf(x, y); }
    return x;
}

constexpr int ML_Q = 0, ML_K = 16384, ML_KE = 32768, ML_V = 49152, ML_P = 65536, ML_ARR = 73728;
DI void mlstm_gates(const Frame& F, int b, int h, int c, int lane, LAS float* GA, LAS float* GPM, LAS float* GBC) {
    const size_t m = (size_t)(b * SEQ + c * CH + lane);
    const float li = F.GATES[m * 32 + 12 + h] + F.i_bias[h];
    const float lf = -softplusf_(-(F.GATES[m * 32 + 18 + h] + F.f_bias[h]));
    const float bc = wave_incl_sum(lf, lane);
    const float a = li - bc;
    const float pm = wave_incl_max(a, lane);
    const int p = (c & 1) * 64;
    GA[p + lane] = a; GPM[p + lane] = pm; GBC[p + lane] = bc;
}
DI void mlstm_item(Frame& F, int item) {
    const int b = item / 6, h = item % 6, tid = F.tid, lane = F.lane, w = F.wave, lr = lane & 15, g = lane >> 4;
    LAS unsigned char* Qi = F.lds + RING_OFF + ML_Q; LAS unsigned char* Ki = F.lds + RING_OFF + ML_K; LAS unsigned char* KEi = F.lds + RING_OFF + ML_KE;
    LAS unsigned char* Vi = F.lds + RING_OFF + ML_V; LAS unsigned char* Pi = F.lds + RING_OFF + ML_P;
    LAS float* GA = (LAS float*)(F.lds + RING_OFF + ML_ARR); LAS float* GPM = GA + 128; LAS float* GBC = GPM + 128;
    LAS float* DEN1P = GBC + 128; LAS float* DEN2 = DEN1P + 256; LAS float* SS = DEN2 + 64; LAS float* NV = SS + 512;
    f32x4 Cw[8];
#pragma unroll
    for (int i = 0; i < 8; ++i) Cw[i] = (f32x4){0.f, 0.f, 0.f, 0.f};
    float m_st = 0.f;
    __syncthreads();
    if (tid < 128) NV[tid] = 0.f;
    if (w == 0) mlstm_gates(F, b, h, 0, lane, GA, GPM, GBC);
    v4u pre[6];
#define ML_LOAD(c_) do { const size_t m0_ = (size_t)(b * SEQ + (c_) * CH); _Pragma("unroll") for (int i = 0; i < 6; ++i) { const int idx = tid + NTHR * i, mat = idx >> 10, r = (idx >> 4) & 63, ch = idx & 15; \
        pre[i] = *(const GAS v4u*)(F.PROJ + (m0_ + r) * NP + C_MQ + mat * 768 + h * 128 + ch * 8); } } while (0)
#define ML_WRITE(c_, mst_) do { const int p_ = ((c_) & 1) * 64; const float M63_ = GPM[p_ + 63]; const float sl_ = __expf(M63_ - fmaxf((mst_), M63_)) * RSQRT_HD; \
        _Pragma("unroll") for (int i = 0; i < 6; ++i) { const int idx = tid + NTHR * i, mat = idx >> 10, r = (idx >> 4) & 63, ch = idx & 15; \
            if (mat == 0) *(LAS v4u*)(Qi + img_off(r, ch)) = pre[i]; \
            else if (mat == 2) *(LAS v4u*)(Vi + img_off(r, ch)) = pre[i]; \
            else { *(LAS v4u*)(Ki + img_off(r, ch)) = pre[i]; \
                const float wk = __expf(GA[p_ + r] - M63_) * sl_; \
                v2u lo, hi; lo.x = pk2(bflo(pre[i].x) * wk, bfhi(pre[i].x) * wk); lo.y = pk2(bflo(pre[i].y) * wk, bfhi(pre[i].y) * wk); \
                hi.x = pk2(bflo(pre[i].z) * wk, bfhi(pre[i].z) * wk); hi.y = pk2(bflo(pre[i].w) * wk, bfhi(pre[i].w) * wk); \
                const int a_ = ch >> 2, b_ = ch & 3; \
                *(LAS v2u*)(KEi + img_off(r, 4 * a_ + (b_ >> 1)) + (b_ & 1) * 8) = lo;            \
                *(LAS v2u*)(KEi + img_off(r, 4 * a_ + 2 + (b_ >> 1)) + (b_ & 1) * 8) = hi; }     \
        } } while (0)
    ML_LOAD(0);
    __syncthreads();
    ML_WRITE(0, m_st);
    __syncthreads();
#pragma unroll 1
    for (int c = 0; c < NCH; ++c) {
        const int p = (c & 1) * 64;
        const size_t m0 = (size_t)(b * SEQ + c * CH);
        const float M63 = GPM[p + 63], blast = GBC[p + 63], Mx = fmaxf(m_st, M63), s_old = __expf(m_st - Mx);
        if (c + 1 < NCH) { ML_LOAD(c + 1); if (w == 0) mlstm_gates(F, b, h, c + 1, lane, GA, GPM, GBC); }
        {
            const int t = tid >> 3, part = tid & 7;
            const v4u q0 = *(const LAS v4u*)(Qi + img_off(t, 2 * part)), q1 = *(const LAS v4u*)(Qi + img_off(t, 2 * part + 1));
            const LAS f32x4* nv = (const LAS f32x4*)(NV + 16 * part);
            const f32x4 n0 = nv[0], n1 = nv[1], n2 = nv[2], n3 = nv[3];
            float s = bflo(q0.x) * n0[0] + bfhi(q0.x) * n0[1] + bflo(q0.y) * n0[2] + bfhi(q0.y) * n0[3] + bflo(q0.z) * n1[0] + bfhi(q0.z) * n1[1] + bflo(q0.w) * n1[2] + bfhi(q0.w) * n1[3]
                    + bflo(q1.x) * n2[0] + bfhi(q1.x) * n2[1] + bflo(q1.y) * n2[2] + bfhi(q1.y) * n2[3] + bflo(q1.z) * n3[0] + bfhi(q1.z) * n3[1] + bflo(q1.w) * n3[2] + bfhi(q1.w) * n3[3];
            s += __shfl_xor(s, 1); s += __shfl_xor(s, 2); s += __shfl_xor(s, 4);
            if (part == 0) DEN2[t] = s;
        }
        {
            const int tt = w >> 1, t = 16 * tt + lr;
            const float pmt = GPM[p + t];
#pragma unroll
            for (int j = 0; j < 2; ++j) {
                const int st = 2 * (w & 1) + j;
                f32x4 acc = {0.f, 0.f, 0.f, 0.f};
                if (st <= tt) {
#pragma unroll
                    for (int ks = 0; ks < 4; ++ks) acc = MFMA16(row_frag(Ki, 16 * st + lr, ks, g), row_frag(Qi, t, ks, g), acc);
                }
                float pv[4], ps = 0.f;
#pragma unroll
                for (int r = 0; r < 4; ++r) { const int s = 16 * st + 4 * g + r; pv[r] = (s <= t) ? __expf(GA[p + s] - pmt) * RSQRT_HD * acc[r] : 0.f; ps += pv[r]; }
                ps += __shfl_xor(ps, 16); ps += __shfl_xor(ps, 32);
                if (g == 0) DEN1P[st * 64 + t] = ps;
                v2u o; o.x = cvt_pk_bf16(pv[0], pv[1]); o.y = cvt_pk_bf16(pv[2], pv[3]);
                *(LAS v2u*)(Pi + t * 128 + (((2 * st + (g >> 1)) ^ (t & 7)) << 4) + (g & 1) * 8) = o;
            }
        }
        __syncthreads();
        f32x4 x1[4], x2[4];
        {
            bf16x8 vf[2], pc[4];
#pragma unroll
            for (int ks = 0; ks < 2; ++ks) vf[ks] = tr_frag(Vi, 32 * ks, 16 * w, lane);
#pragma unroll
            for (int ks = 0; ks < 4; ++ks) pc[ks] = pack8(Cw[2 * ks], Cw[2 * ks + 1]);
#pragma unroll
            for (int tt = 0; tt < 4; ++tt) {
                const int t = 16 * tt + lr;
                f32x4 a1 = {0.f, 0.f, 0.f, 0.f}, a2 = {0.f, 0.f, 0.f, 0.f};
#pragma unroll
                for (int ks = 0; ks < 2; ++ks) { const bf16x8 pf = *(const LAS bf16x8*)(Pi + t * 128 + (((4 * ks + g) ^ (t & 7)) << 4)); a1 = MFMA16(vf[ks], pf, a1); }
#pragma unroll
                for (int ks = 0; ks < 4; ++ks) a2 = MFMA16(pc[ks], row_frag(Qi, t, ks, g), a2);
                x1[tt] = a1; x2[tt] = a2;
            }
#pragma unroll
            for (int dt = 0; dt < 8; ++dt) Cw[dt] = Cw[dt] * s_old;
            bf16x8 ones; { const short o1 = (short)0x3F80;
#pragma unroll
                for (int i = 0; i < 8; ++i) ones[i] = o1; }
            f32x4 ninc = {0.f, 0.f, 0.f, 0.f};
#pragma unroll
            for (int dt = 0; dt < 8; ++dt)
#pragma unroll
                for (int ks = 0; ks < 2; ++ks) { const bf16x8 kf = tr_frag(KEi, 32 * ks, 16 * dt, lane); Cw[dt] = MFMA16(kf, vf[ks], Cw[dt]); if (dt == w) ninc = MFMA16(ones, kf, ninc); }
            if (g == 0) { const int d = 32 * (w >> 1) + 8 * (lr >> 2) + 4 * (w & 1) + (lr & 3); NV[d] = s_old * NV[d] + ninc[0]; }
        }
        float hv[4][4];
        {
            const float* mlg = F.ml_ng + h * 128 + 16 * w + 4 * g; (void)mlg;
#pragma unroll
            for (int tt = 0; tt < 4; ++tt) {
                const int t = 16 * tt + lr;
                const float pmt = GPM[p + t], Mt = fmaxf(m_st, pmt), At = __expf(m_st - Mt), Rt = __expf(pmt - Mt), em = __expf(-(GBC[p + t] + Mt));
                const float den = At * DEN2[t] + Rt * (DEN1P[t] + DEN1P[64 + t] + DEN1P[128 + t] + DEN1P[192 + t]);
                const float idn = 1.f / fmaxf(fabsf(den), em);
                const v2u mo = *(const GAS v2u*)(F.PROJ + (m0 + t) * NP + C_MO + h * 128 + 16 * w + 4 * g);
                const float o0 = sigmoidf_(bflo(mo.x)), o1 = sigmoidf_(bfhi(mo.x)), o2 = sigmoidf_(bflo(mo.y)), o3 = sigmoidf_(bfhi(mo.y));
                hv[tt][0] = (At * x2[tt][0] + Rt * x1[tt][0]) * idn * o0; hv[tt][1] = (At * x2[tt][1] + Rt * x1[tt][1]) * idn * o1;
                hv[tt][2] = (At * x2[tt][2] + Rt * x1[tt][2]) * idn * o2; hv[tt][3] = (At * x2[tt][3] + Rt * x1[tt][3]) * idn * o3;
                float ss = hv[tt][0] * hv[tt][0] + hv[tt][1] * hv[tt][1] + hv[tt][2] * hv[tt][2] + hv[tt][3] * hv[tt][3];
                ss += __shfl_xor(ss, 16); ss += __shfl_xor(ss, 32);
                if (g == 0) SS[w * 64 + t] = ss;
            }
        }
        __syncthreads();
        {
            const f32x4 gn = *(const GAS f32x4*)(F.ml_ng + h * 128 + 16 * w + 4 * g);
#pragma unroll
            for (int tt = 0; tt < 4; ++tt) {
                const int t = 16 * tt + lr;
                float ss = 0.f;
#pragma unroll
                for (int j = 0; j < 8; ++j) ss += SS[j * 64 + t];
                const float rstd = 1.f / sqrtf(ss * (1.f / 128.f) + EPS);
                const v2u mz = *(const GAS v2u*)(F.PROJ + (m0 + t) * NP + C_MZ + h * 128 + 16 * w + 4 * g);
                v2u o; o.x = pk2(hv[tt][0] * rstd * gn[0] * siluf_(bflo(mz.x)), hv[tt][1] * rstd * gn[1] * siluf_(bfhi(mz.x)));
                o.y = pk2(hv[tt][2] * rstd * gn[2] * siluf_(bflo(mz.y)), hv[tt][3] * rstd * gn[3] * siluf_(bfhi(mz.y)));
                *(GAS v2u*)(F.PROJ + (m0 + t) * NP + C_MV + h * 128 + 16 * w + 4 * g) = o;
            }
        }
        m_st = blast + Mx;
        if (c + 1 < NCH) ML_WRITE(c + 1, m_st);
        __syncthreads();
    }
#undef ML_LOAD
#undef ML_WRITE
}

constexpr size_t CHK_STRIDE = 18432, CHK_NA = 0, CHK_ATT = 8192, CHK_DI = 16384;
constexpr int GD_Q = 0, GD_K = 16384, GD_V = 32768, GD_NA = 49152, GD_AT = 57344, GD_DI = 65536, GD_ARR = 67584;
DI bf16x8 row_frag_perm(const LAS unsigned char* img, int row, int ks, int g) {
    const v2u lo = *(const LAS v2u*)(img + img_off(row, 4 * ks + (g >> 1)) + (g & 1) * 8), hi = *(const LAS v2u*)(img + img_off(row, 4 * ks + 2 + (g >> 1)) + (g & 1) * 8);
    return __builtin_bit_cast(bf16x8, (v4u){lo.x, lo.y, hi.x, hi.y});
}
DI unsigned sq_off(int row, int ch) { return 128u * (unsigned)row + 16u * (unsigned)(ch ^ ((row >> 1) & 7)); }
DI bf16x8 sq_frag_perm(const LAS unsigned char* img, int row, int ks, int g) {
    const v2u lo = *(const LAS v2u*)(img + sq_off(row, 4 * ks + (g >> 1)) + (g & 1) * 8), hi = *(const LAS v2u*)(img + sq_off(row, 4 * ks + 2 + (g >> 1)) + (g & 1) * 8);
    return __builtin_bit_cast(bf16x8, (v4u){lo.x, lo.y, hi.x, hi.y});
}
DI bf16x8 tr_frag_perm(LAS unsigned char* img, int row0, int col0, int lane) {
    const int i = lane & 15, g = lane >> 4, r0 = row0 + 4 * g + (i >> 2), c = col0 + 4 * (i & 3);
    const s16x4 a = __builtin_amdgcn_ds_read_tr16_b64_v4i16((LAS s16x4*)(img + img_off(r0, c >> 3) + (c & 4) * 2));
    const s16x4 b = __builtin_amdgcn_ds_read_tr16_b64_v4i16((LAS s16x4*)(img + img_off(r0 + 16, c >> 3) + (c & 4) * 2));
    return (bf16x8){a[0], a[1], a[2], a[3], b[0], b[1], b[2], b[3]};
}
DI void gdn_gates(const Frame& F, int b, int h, int c, int lane, LAS float* GC, LAS float* BE) {
    const size_t m = (size_t)(b * SEQ + c * CH + lane);
    const float gl = gate_transform(F, h, F.GATES[m * 32 + h]);
    const int p = (c & 1) * 64;
    GC[p + lane] = wave_incl_sum(gl, lane); BE[p + lane] = gate_transform(F, 6 + h, F.GATES[m * 32 + 6 + h]);
}
DI void gdn_item(Frame& F, int item) {
    const int b = item / 6, h = item % 6, tid = F.tid, lane = F.lane, w = F.wave, lr = lane & 15, g = lane >> 4;
    LAS unsigned char* Qi = F.lds + RING_OFF + GD_Q; LAS unsigned char* Ki = F.lds + RING_OFF + GD_K; LAS unsigned char* Vi = F.lds + RING_OFF + GD_V;
    LAS unsigned char* NAi = F.lds + RING_OFF + GD_NA; LAS unsigned char* ATi = F.lds + RING_OFF + GD_AT; LAS unsigned char* DIi = F.lds + RING_OFF + GD_DI;
    LAS float* GC = (LAS float*)(F.lds + RING_OFF + GD_ARR); LAS float* BE = GC + 128; LAS float* SS = BE + 128;
    f32x4 Sw[8];
#pragma unroll
    for (int i = 0; i < 8; ++i) Sw[i] = (f32x4){0.f, 0.f, 0.f, 0.f};
    __syncthreads();
    if (w == 0) gdn_gates(F, b, h, 0, lane, GC, BE);
    v4u pre[9];
#define GD_LOAD(c_) do { const size_t m0_ = (size_t)(b * SEQ + (c_) * CH); const unsigned char* chk_ = F.CHK + (size_t)((b * NCH + (c_)) * 6 + h) * CHK_STRIDE; \
        _Pragma("unroll") for (int i = 0; i < 6; ++i) { const int idx = tid + NTHR * i, mat = idx >> 10, r = (idx >> 4) & 63, ch = idx & 15; \
            pre[i] = *(const GAS v4u*)(F.PROJ + (m0_ + r) * NP + mat * 768 + h * 128 + ch * 8); } \
        pre[6] = *(const GAS v4u*)(chk_ + (size_t)tid * 16); pre[7] = *(const GAS v4u*)(chk_ + (size_t)(tid + NTHR) * 16); \
        if (tid < 128) pre[8] = *(const GAS v4u*)(chk_ + CHK_DI + (size_t)tid * 16); } while (0)
#define GD_WRITE() do { \
        _Pragma("unroll") for (int i = 0; i < 6; ++i) { const int idx = tid + NTHR * i, mat = idx >> 10, r = (idx >> 4) & 63, ch = idx & 15; \
            *(LAS v4u*)((mat == 0 ? Qi : (mat == 1 ? Ki : Vi)) + img_off(r, ch)) = pre[i]; } \
        { const int r = tid >> 3, ch = tid & 7; *(LAS v4u*)(NAi + sq_off(r, ch)) = pre[6]; *(LAS v4u*)(ATi + sq_off(r, ch)) = pre[7]; } \
        if (tid < 128) *(LAS v4u*)(DIi + tid * 16) = pre[8]; } while (0)
    GD_LOAD(0);
    GD_WRITE();
    __syncthreads();
#pragma unroll 1
    for (int c = 0; c < NCH; ++c) {
        const int p = (c & 1) * 64;
        const size_t m0 = (size_t)(b * SEQ + c * CH);
        const float gl = GC[p + 63];
        if (c + 1 < NCH) { GD_LOAD(c + 1); if (w == 0) gdn_gates(F, b, h, c + 1, lane, GC, BE); }
        f32x4 ot[4], vn[4];
        {
            bf16x8 sp[4];
#pragma unroll
            for (int ks = 0; ks < 4; ++ks) sp[ks] = pack8(Sw[2 * ks], Sw[2 * ks + 1]);
#pragma unroll
            for (int st = 0; st < 4; ++st) {
                f32x4 ks_ = {0.f, 0.f, 0.f, 0.f}, qs_ = {0.f, 0.f, 0.f, 0.f};
#pragma unroll
                for (int ks = 0; ks < 4; ++ks) { ks_ = MFMA16(row_frag_perm(Ki, 16 * st + lr, ks, g), sp[ks], ks_); qs_ = MFMA16(row_frag_perm(Qi, 16 * st + lr, ks, g), sp[ks], qs_); }
#pragma unroll
                for (int r = 0; r < 4; ++r) {
                    const int s = 16 * st + 4 * g + r, e = 16 * w + lr;
                    const float gcs = GC[p + s], eg = __expf(gcs);
                    const float vv = bf2f(*(const LAS bf16*)(Vi + img_off(s, e >> 3) + (e & 7) * 2));
                    vn[st][r] = BE[p + s] * (vv - eg * ks_[r]);
                    ot[st][r] = qs_[r] * eg;
                }
                asm volatile("" ::: "memory");
            }
            const v2u z2 = {0u, 0u};
            const v2u d0 = *(const LAS v2u*)(DIi + 0 * 512 + lr * 32 + g * 8), d1 = *(const LAS v2u*)(DIi + 1 * 512 + lr * 32 + g * 8);
            const v2u d2 = *(const LAS v2u*)(DIi + 2 * 512 + lr * 32 + g * 8), d3 = *(const LAS v2u*)(DIi + 3 * 512 + lr * 32 + g * 8);
            const bf16x8 di0 = __builtin_bit_cast(bf16x8, (v4u){d0.x, d0.y, z2.x, z2.y}), di1 = __builtin_bit_cast(bf16x8, (v4u){z2.x, z2.y, d1.x, d1.y});
            const bf16x8 di2 = __builtin_bit_cast(bf16x8, (v4u){d2.x, d2.y, z2.x, z2.y}), di3 = __builtin_bit_cast(bf16x8, (v4u){z2.x, z2.y, d3.x, d3.y});
            const f32x4 zero4 = {0.f, 0.f, 0.f, 0.f};
            vn[0] = MFMA16(di0, pack8(vn[0], vn[1]), zero4);
            vn[1] = MFMA16(sq_frag_perm(NAi, 16 + lr, 0, g), pack8(vn[0], vn[1]), vn[1]);
            vn[1] = MFMA16(di1, pack8(vn[0], vn[1]), zero4);
            { const bf16x8 p01 = pack8(vn[0], vn[1]);
              vn[2] = MFMA16(sq_frag_perm(NAi, 32 + lr, 0, g), p01, vn[2]);
              vn[3] = MFMA16(sq_frag_perm(NAi, 48 + lr, 0, g), p01, vn[3]); }
            vn[2] = MFMA16(di2, pack8(vn[2], vn[3]), zero4);
            vn[3] = MFMA16(sq_frag_perm(NAi, 48 + lr, 1, g), pack8(vn[2], vn[3]), vn[3]);
            vn[3] = MFMA16(di3, pack8(vn[2], vn[3]), zero4);
            {
                const bf16x8 p01 = pack8(vn[0], vn[1]), p23 = pack8(vn[2], vn[3]);
#pragma unroll
                for (int tt = 0; tt < 4; ++tt) {
                    ot[tt] = MFMA16(sq_frag_perm(ATi, 16 * tt + lr, 0, g), p01, ot[tt]);
                    if (tt >= 2) ot[tt] = MFMA16(sq_frag_perm(ATi, 16 * tt + lr, 1, g), p23, ot[tt]);
                }
            }
            f32x4 vd[4];
#pragma unroll
            for (int st = 0; st < 4; ++st)
#pragma unroll
                for (int r = 0; r < 4; ++r) vd[st][r] = vn[st][r] * __expf(gl - GC[p + 16 * st + 4 * g + r]);
            const bf16x8 q01 = pack8(vd[0], vd[1]), q23 = pack8(vd[2], vd[3]);
            const float egl = __expf(gl);
#pragma unroll
            for (int dt = 0; dt < 8; ++dt) {
                Sw[dt] = Sw[dt] * egl;
                Sw[dt] = MFMA16(tr_frag_perm(Ki, 0, 16 * dt, lane), q01, Sw[dt]);
                Sw[dt] = MFMA16(tr_frag_perm(Ki, 32, 16 * dt, lane), q23, Sw[dt]);
                if (dt & 1) asm volatile("" ::: "memory");
            }
        }
#pragma unroll
        for (int tt = 0; tt < 4; ++tt)
#pragma unroll
            for (int r = 0; r < 4; ++r) {
                float ss = ot[tt][r] * ot[tt][r];
                ss += __shfl_xor(ss, 1); ss += __shfl_xor(ss, 2); ss += __shfl_xor(ss, 4); ss += __shfl_xor(ss, 8);
                if (lr == 0) SS[w * 64 + 16 * tt + 4 * g + r] = ss;
            }
        __syncthreads();
        {
            const int e = 16 * w + lr;
            const float gn = F.gdn_ng[e];
#pragma unroll
            for (int tt = 0; tt < 4; ++tt)
#pragma unroll
                for (int r = 0; r < 4; ++r) {
                    const int t = 16 * tt + 4 * g + r;
                    float ss = 0.f;
#pragma unroll
                    for (int j = 0; j < 8; ++j) ss += SS[j * 64 + t];
                    const float rstd = 1.f / sqrtf(ss * (1.f / 128.f) + EPS);
                    const float z = bf2f(F.PROJ[(m0 + t) * NP + C_GZ + h * 128 + e]);
                    F.PROJ[(m0 + t) * NP + C_GV + h * 128 + e] = (bf16)f2bf(ot[tt][r] * rstd * gn * siluf_(z));
                }
        }
        if (c + 1 < NCH) GD_WRITE();
        __syncthreads();
    }
#undef GD_LOAD
#undef GD_WRITE
}

DI void gdn_prep_item(Frame& F, int item) {
    const int h = item % 6, bc = item / 6, c = bc & 63, b = bc >> 6, tid = F.tid;
    const int ch = tid & 15, rg = (tid >> 4) & 7, mat = tid >> 7;
    const size_t m0 = (size_t)(b * SEQ + c * CH);
    v4u ov[8];
    if (mat < 3) {
        const int col = mat * 768 + h * 128 + ch * 8;
        float wgt[4][8];
#pragma unroll
        for (int j = 0; j < 4; ++j) { const f32x4 w0 = *(const GAS f32x4*)(F.conv_w + j * 2304 + col), w1 = *(const GAS f32x4*)(F.conv_w + j * 2304 + col + 4);
            wgt[j][0] = w0[0]; wgt[j][1] = w0[1]; wgt[j][2] = w0[2]; wgt[j][3] = w0[3]; wgt[j][4] = w1[0]; wgt[j][5] = w1[1]; wgt[j][6] = w1[2]; wgt[j][7] = w1[3]; }
        v4u xr[11];
#pragma unroll
        for (int i = 0; i < 11; ++i) {
            const int r = 8 * rg - 3 + i;
            if (r >= 0) xr[i] = *(const GAS v4u*)(F.PROJ + (m0 + r) * NP + col);
            else if (c > 0) xr[i] = *(const GAS v4u*)(F.HALO + ((size_t)(b * 64 + c - 1) * 3 + (r + 3)) * 2304 + col);
            else xr[i] = (v4u){0u, 0u, 0u, 0u};
        }
        float y[8][8];
#pragma unroll
        for (int r = 0; r < 8; ++r)
#pragma unroll
            for (int e = 0; e < 8; ++e) y[r][e] = 0.f;
#pragma unroll
        for (int i = 0; i < 11; ++i) {
            const float xv[8] = {bflo(xr[i].x), bfhi(xr[i].x), bflo(xr[i].y), bfhi(xr[i].y), bflo(xr[i].z), bfhi(xr[i].z), bflo(xr[i].w), bfhi(xr[i].w)};
#pragma unroll
            for (int j = 0; j < 4; ++j) { const int r = i - j;
                if (r >= 0 && r < 8) {
#pragma unroll
                    for (int e = 0; e < 8; ++e) y[r][e] += wgt[j][e] * xv[e]; } }
        }
#pragma unroll
        for (int r = 0; r < 8; ++r) {
            float ss = 0.f;
#pragma unroll
            for (int e = 0; e < 8; ++e) { y[r][e] = siluf_(y[r][e]); ss += y[r][e] * y[r][e]; }
            float sc = 1.f;
            if (mat < 2) { ss += __shfl_xor(ss, 1); ss += __shfl_xor(ss, 2); ss += __shfl_xor(ss, 4); ss += __shfl_xor(ss, 8); sc = (1.f / sqrtf(ss + EPS)) * (mat == 0 ? RSQRT_HD : 1.f); }
            ov[r].x = pk2(y[r][0] * sc, y[r][1] * sc); ov[r].y = pk2(y[r][2] * sc, y[r][3] * sc); ov[r].z = pk2(y[r][4] * sc, y[r][5] * sc); ov[r].w = pk2(y[r][6] * sc, y[r][7] * sc);
        }
    }
    LAS unsigned char* Qi = F.lds + RING_OFF; LAS unsigned char* Ki = F.lds + RING_OFF + 16384;
    LAS float* LB = (LAS float*)(F.lds + RING_OFF + 32768);
    LAS float* GC = LB + 1024; LAS float* BE = GC + 64;
    if (mat < 2) {
#pragma unroll
        for (int r = 0; r < 8; ++r) *(LAS v4u*)((mat == 0 ? Qi : Ki) + img_off(8 * rg + r, ch)) = ov[r];
    }
    if (F.wave == 7) {
        const float gl = gate_transform(F, h, F.GATES[(m0 + F.lane) * 32 + h]);
        GC[F.lane] = wave_incl_sum(gl, F.lane); BE[F.lane] = gate_transform(F, 6 + h, F.GATES[(m0 + F.lane) * 32 + 6 + h]);
    }
    __syncthreads();
    if (mat < 3) {
        const int col = mat * 768 + h * 128 + ch * 8;
#pragma unroll
        for (int r = 0; r < 8; ++r) *(GAS v4u*)(F.PROJ + (m0 + 8 * rg + r) * NP + col) = ov[r];
    }
    {
        const int lane = F.lane, w = F.wave, lr = lane & 15, g = lane >> 4;
        unsigned char* chk = F.CHK + (size_t)item * CHK_STRIDE;
        for (int id = w; id < 20; id += 8) {
            const int kind = id >= 10 ? 1 : 0, idx = id - 10 * kind;
            const int it = idx >= 6 ? 3 : (idx >= 3 ? 2 : (idx >= 1 ? 1 : 0)), jt = idx - (it * (it + 1)) / 2;
            f32x4 acc = {0.f, 0.f, 0.f, 0.f};
#pragma unroll
            for (int ks = 0; ks < 4; ++ks) acc = MFMA16(row_frag(Ki, 16 * jt + lr, ks, g), row_frag(kind ? Qi : Ki, 16 * it + lr, ks, g), acc);
            const int i = 16 * it + lr;
            const float gci = GC[i], bei = BE[i];
            float val[4];
#pragma unroll
            for (int r = 0; r < 4; ++r) { const int j = 16 * jt + 4 * g + r; const float dec = __expf(gci - GC[j]);
                val[r] = kind ? (i >= j ? acc[r] * dec : 0.f) : (i > j ? bei * acc[r] * dec : 0.f); }
            if (kind) {
                v2u o; o.x = cvt_pk_bf16(val[0], val[1]); o.y = cvt_pk_bf16(val[2], val[3]);
                *(GAS v2u*)(chk + CHK_ATT + (size_t)i * 128 + (16 * jt + 4 * g) * 2) = o;
                if (jt == it && !(it & 1)) *(GAS v2u*)(chk + CHK_ATT + (size_t)i * 128 + (16 * (jt + 1) + 4 * g) * 2) = (v2u){0u, 0u};
            } else if (jt < it) {
                v2u o; o.x = cvt_pk_bf16(-val[0], -val[1]); o.y = cvt_pk_bf16(-val[2], -val[3]);
                *(GAS v2u*)(chk + CHK_NA + (size_t)i * 128 + (16 * jt + 4 * g) * 2) = o;
            } else {
                *(LAS f32x4*)(LB + it * 256 + lr * 16 + 4 * g) = (f32x4){val[0], val[1], val[2], val[3]};
                *(GAS v2u*)(chk + CHK_NA + (size_t)i * 128 + (16 * jt + 4 * g) * 2) = (v2u){0u, 0u};
            }
        }
        __syncthreads();
        if (w == 0) {
            const int blk = lane >> 4, col = lane & 15;
            const LAS float* L = LB + blk * 256;
            float xv[16];
#pragma unroll
            for (int i2 = 0; i2 < 16; ++i2) {
                float sacc = (i2 == col) ? 1.f : 0.f;
#pragma unroll
                for (int j2 = 0; j2 < i2; ++j2) sacc -= L[i2 * 16 + j2] * xv[j2];
                xv[i2] = sacc;
                *(GAS bf16*)(chk + CHK_DI + (size_t)(blk * 256 + i2 * 16 + col) * 2) = (bf16)f2bf(sacc);
            }
        }
        __syncthreads();
    }
}
DI void p2a_prep(Frame& F) {
    for (int it = F.vcu; it < BATCH * NCH * 6; it += F.G) gdn_prep_item(F, it);
}

DI void p2_mixers_ref(Frame& F) {
    if (F.G < 128) return;
    if (F.vcu < 48) gdn_item(F, F.vcu);
    else if (F.vcu < 96) mlstm_item(F, F.vcu - 48);
    else for (int it = F.vcu - 96; it < BATCH * 4 * 16; it += F.G - 96) xattn_item(F, it);
}

struct Args { const float* in[15]; float* out; unsigned char* ws; int ph_lo, ph_hi, li, pad; };
__global__ void __launch_bounds__(NTHR, 2) hyb_fwd(Args args) {
    extern __shared__ __attribute__((aligned(16))) unsigned char lds[];
    Frame F;
    F.lds = (LAS unsigned char*)lds;
    F.MISC = (volatile LAS unsigned*)(F.lds + MISC_OFF);
    F.tid = threadIdx.x; F.lane = F.tid & 63; F.wave = __builtin_amdgcn_readfirstlane(F.tid >> 6);
    F.G = gridDim.x; { const int bx = blockIdx.x; F.vcu = (F.G % 8 == 0) ? (bx % 8) * (F.G / 8) + bx / 8 : bx; }
    unsigned char* ws = args.ws;
    F.ctl = (gu32*)(ws + WS_CTL);
    F.x = args.in[0]; F.mem = args.in[1]; F.norm_g = args.in[2]; F.w_in = args.in[3]; F.conv_w = args.in[4]; F.a_log = args.in[5]; F.dt_bias = args.in[6];
    F.gdn_ng = args.in[7]; F.i_bias = args.in[8]; F.f_bias = args.in[9]; F.ml_ng = args.in[10]; F.mem_ng = args.in[11]; F.w_kv = args.in[12]; F.w_out = args.in[13]; F.fin_g = args.in[14];
    F.out = args.out;
    F.HALO = (bf16*)((unsigned char*)args.out + DO_HALO); F.CHK = (unsigned char*)args.out + DO_CHK; F.XN = (bf16*)((unsigned char*)args.out + DO_XN); F.WIN = (bf16*)((unsigned char*)args.out + DO_WIN);
    F.WOUT = (bf16*)(ws + WS_WOUT); F.KV = (bf16*)(ws + WS_KV); F.KM = F.KV; F.VT = F.KV + (size_t)MMEM * 512; F.GATES = (float*)(ws + WS_GATES); F.PROJ = (bf16*)(ws + WS_PROJ);
    for (int u = F.tid; u < (XTRA_OFF - LDSCTL_OFF) / 4; u += NTHR) ((LAS unsigned*)(F.lds + LDSCTL_OFF))[u] = 0u;
    __syncthreads();
    XcdBarrier bar; bar.bar = (unsigned*)(F.ctl + CW_BAR); bar.x = 0; bar.st = nullptr;
    if (N_LAUNCHES != PER_PHASE) bar = xcd_barrier_post((unsigned*)(F.ctl + CW_BAR), F.MISC + 8);
#define GRID_BAR(seam) do { if (N_LAUNCHES == PER_PHASE) { if (F.tid == 0) __hip_atomic_store(F.ctl + CW_TMO, 0xBADBA0u | (unsigned)(seam), RLX_AGENT); } else { xcd_barrier(bar); } } while (0)
    const int lo = args.ph_lo, hi = args.ph_hi;
#define IN(k) (lo <= (k) && (k) < hi)
#define BOTH(k) (IN(k) && IN((k) + 1))
    if (IN(0)) { p0_prologue(F); if (BOTH(0)) GRID_BAR(0); }
    if (IN(1)) { p1_gemm_in(F); if (BOTH(1)) GRID_BAR(1); }
    if (IN(2)) { p2a_prep(F); GRID_BAR(5); p2_mixers_ref(F); if (BOTH(2)) GRID_BAR(2); }
    if (IN(3)) { p3_gemm_out(F); if (BOTH(3)) GRID_BAR(3); }
    if (IN(4)) { p4_final_norm(F); }
#undef IN
#undef BOTH
}

extern "C" void kernel_launch(void* const* d_in, const int* in_sizes, int n_in, void* d_out, int out_size, void* d_ws, size_t ws_size, hipStream_t stream) {
    static int grid = 0;
    if (grid == 0) {
        if (n_in != 15 || in_sizes[0] != MTOK * DM || out_size != MTOK * DM || ws_size < WS_END) { fprintf(stderr, "kernel_launch: unexpected shapes / workspace (%zu < %zu)\n", ws_size, (size_t)WS_END); grid = -1; return; }
        int dev = 0, cus = 0, per_cu = 0;
        if (hipGetDevice(&dev) != hipSuccess || hipDeviceGetAttribute(&cus, hipDeviceAttributeMultiprocessorCount, dev) != hipSuccess) { grid = -1; return; }
        if (hipFuncSetAttribute((const void*)hyb_fwd, hipFuncAttributeMaxDynamicSharedMemorySize, LDS_BYTES) != hipSuccess) { grid = -1; return; }
        if (hipOccupancyMaxActiveBlocksPerMultiprocessor(&per_cu, (const void*)hyb_fwd, NTHR, LDS_BYTES) != hipSuccess || per_cu < 1)
            fprintf(stderr, "kernel_launch: occupancy query reports %d workgroups per CU\n", per_cu);
        (void)hipGetLastError();
        grid = cus;
    }
    if (grid < 0) return;
    if (hipMemsetAsync((char*)d_ws + WS_CTL, 0, CTL_ZERO_BYTES, stream) != hipSuccess) return;
    Args a{};
    for (int i = 0; i < 15; ++i) a.in[i] = (const float*)d_in[i];
    a.out = (float*)d_out; a.ws = (unsigned char*)d_ws;
    const int nl = N_LAUNCHES == PER_PHASE ? PER_PHASE : 1;
    for (int li = 0; li < nl; ++li) {
        a.ph_lo = (N_LAUNCHES == PER_PHASE) ? li : 0; a.ph_hi = (N_LAUNCHES == PER_PHASE) ? li + 1 : PER_PHASE; a.li = li;
        hipLaunchKernelGGL(hyb_fwd, dim3(grid), dim3(NTHR), LDS_BYTES, stream, a);
        if (hipPeekAtLastError() != hipSuccess) break;
    }
}
```

```cpp
#include <hip/hip_runtime.h>
#include <cstdio>
#include <cstdint>

#define GAS __attribute__((address_space(1)))
#define LAS __attribute__((address_space(3)))
typedef unsigned short bf16;
typedef unsigned v4u __attribute__((ext_vector_type(4)));
typedef unsigned v2u __attribute__((ext_vector_type(2)));
typedef float f32x4 __attribute__((ext_vector_type(4)));
typedef GAS unsigned gu32;
#define RLX_AGENT __ATOMIC_RELAXED, __HIP_MEMORY_SCOPE_AGENT
#define LDS_WAIT() asm volatile("s_waitcnt lgkmcnt(0)" ::: "memory")
#define VM_WAIT() asm volatile("s_waitcnt vmcnt(0)" ::: "memory")
#define DI __device__ __forceinline__

constexpr int NWAVES = 8, NTHR = 512;
#ifndef MK_N_LAUNCHES
#define MK_N_LAUNCHES 1
#endif
constexpr int PER_PHASE = 5;
constexpr int N_LAUNCHES = MK_N_LAUNCHES;

constexpr int BATCH = 8, SEQ = 4096, DM = 1024, MTOK = BATCH * SEQ, NMEM = 256, MMEM = BATCH * NMEM;
constexpr int HD = 128, NCH = 64, CH = 64;
constexpr int IN_COLS = 7960, NP = 7936, NG = 8192, NKV = 1024, KOUT = 2048;
constexpr int C_GQ = 0, C_GK = 768, C_GV = 1536, C_GZ = 2304, C_MQ = 3072, C_MK = 3840, C_MV = 4608, C_MO = 5376, C_MZ = 6144, C_XQ = 6912, C_XZ = 7424;
constexpr float EPS = 1e-6f;
constexpr float RSQRT_HD = 0.08838834764831845f;

constexpr size_t MiB = 1u << 20;
constexpr size_t WS_CTL = 0, CTL_ZERO_BYTES = 1 * MiB;
constexpr size_t WS_WOUT = 1 * MiB;
constexpr size_t WS_KV = 5 * MiB;
constexpr size_t WS_GATES = 9 * MiB;
constexpr size_t WS_PROJ = 13 * MiB;
constexpr size_t WS_END = WS_PROJ + (size_t)MTOK * NP * 2;
constexpr size_t DO_XN = 0;
constexpr size_t DO_WIN = 68 * MiB;
static_assert(DO_WIN == (size_t)(MTOK + MMEM) * DM * 2, "WIN follows XN");
static_assert(DO_XN + (size_t)(MTOK + MMEM) * DM * 2 <= DO_WIN && DO_WIN + (size_t)(NG + NKV) * DM * 2 <= (size_t)MTOK * DM * 4, "d_out scratch map");
constexpr size_t DO_CHK = 0;
constexpr size_t DO_GSC = 56 * MiB;
constexpr size_t DO_STML = 62 * MiB;
constexpr size_t DO_STGD = 87 * MiB;
constexpr int ST_ML = 16640, NSEG = 8, SEGC = NCH / NSEG;
static_assert(DO_CHK + (size_t)BATCH * NCH * 6 * 18432 <= DO_GSC && DO_GSC + (size_t)BATCH * NCH * 6 * 448 * 4 <= DO_STML && DO_STML + (size_t)48 * NSEG * ST_ML * 4 <= DO_STGD && DO_STGD + (size_t)48 * NSEG * 98304 <= (size_t)MTOK * DM * 4, "d_out scratch map (P2)");
constexpr size_t DO_HALO = 96 * MiB;
constexpr int CW_TMO = 0, CW_CODE = 1, CW_BAR = 4096;

constexpr int RING_OFF = 0, RING_BYTES = 131072;
constexpr int LDSCTL_OFF = RING_BYTES, MISC_OFF = LDSCTL_OFF + 320, XTRA_OFF = LDSCTL_OFF + 512;
constexpr int LDS_BYTES = 147456;
constexpr int XTRA_BYTES = LDS_BYTES - XTRA_OFF;

DI float bf2f(unsigned short b) { return __builtin_bit_cast(float, ((unsigned)b) << 16); }
DI float bflo(unsigned u) { return __builtin_bit_cast(float, u << 16); }
DI float bfhi(unsigned u) { return __builtin_bit_cast(float, u & 0xffff0000u); }
DI unsigned f2bf(float f) { unsigned u = __builtin_bit_cast(unsigned, f); return (u + 0x7fffu + ((u >> 16) & 1u)) >> 16; }
DI unsigned pk2(float lo, float hi) { return f2bf(lo) | (f2bf(hi) << 16); }
DI float wave_sum(float v) {
#pragma unroll
    for (int o = 1; o < 64; o <<= 1) v += __shfl_xor(v, o);
    return v;
}
DI float wave_max(float v) {
#pragma unroll
    for (int o = 1; o < 64; o <<= 1) v = fmaxf(v, __shfl_xor(v, o));
    return v;
}
DI float sigmoidf_(float x) { return 1.0f / (1.0f + __expf(-x)); }
DI float siluf_(float x) { return x / (1.0f + __expf(-x)); }
DI float softplusf_(float x) { return x > 20.f ? x : log1pf(__expf(x)); }

#define XB_TMO      128
#define XB_XCNT(j)  (256  + 64 * (j))
#define XB_XSUB(j)  (1280 + 64 * (j))
#define XB_XGEN(j)  (2304 + 64 * (j))
#define XB_TOP      3328
#define XB_TOPGEN   3392
#define XCD_BAR_WORDS 3456
#define XB_SPIN_CAP (1u << 18)
DI unsigned xb_ld(unsigned* p)              { return __hip_atomic_load(p, __ATOMIC_RELAXED, __HIP_MEMORY_SCOPE_AGENT); }
DI unsigned xb_add(unsigned* p, unsigned v) { return __hip_atomic_fetch_add(p, v, __ATOMIC_RELAXED, __HIP_MEMORY_SCOPE_AGENT); }
DI unsigned xb_xcc_id() { return (unsigned)__builtin_amdgcn_s_getreg((3 << 11) | 20) & 0xFu; }
#define XB_SPIN(cond, bar) do { unsigned _sp = 0; while (cond) { __builtin_amdgcn_s_sleep(1); \
    if ((++_sp & 255u) == 0u) { if (xb_ld(&(bar)[XB_TMO])) break; if (_sp > XB_SPIN_CAP) { atomicAdd(&(bar)[XB_TMO], 1u); break; } } } } while (0)
struct XcdBarrier { unsigned* bar; unsigned x; volatile LAS unsigned* st; };
DI XcdBarrier xcd_barrier_post(unsigned* bar, volatile LAS unsigned* st) {
    XcdBarrier b; b.bar = bar; b.x = xb_xcc_id(); b.st = st;
    if (threadIdx.x == 0) (void)xb_add(&bar[XB_XCNT(b.x)], 1u);
    return b;
}
DI void xcd_barrier_complete(unsigned* bar, unsigned x, unsigned& nloc, unsigned& nx) {
    const unsigned G = gridDim.x * gridDim.y * gridDim.z;
    unsigned sum, cnt, mine, sp = 0u;
    for (;;) {
        sum = 0u; cnt = 0u; mine = 0u;
#pragma unroll
        for (unsigned j = 0; j < 16; ++j) { const unsigned c = xb_ld(&bar[XB_XCNT(j)]); sum += c; cnt += (c > 0u) ? 1u : 0u; mine = (j == x) ? c : mine; }
        if (sum == G) break;
        __builtin_amdgcn_s_sleep(1);
        if ((++sp & 255u) == 0u) { if (xb_ld(&bar[XB_TMO])) break; if (sp > XB_SPIN_CAP) { atomicAdd(&bar[XB_TMO], 1u); break; } }
    }
    nloc = mine > 0u ? mine : 1u; nx = cnt > 0u ? cnt : 1u;
}
DI void xcd_barrier(const XcdBarrier& b) {
    asm volatile("s_waitcnt vmcnt(0)" ::: "memory");
    __syncthreads();
    if (threadIdx.x == 0) {
        unsigned* bar = b.bar;
        __builtin_amdgcn_s_waitcnt(0);
        unsigned nloc = b.st[0], nx = b.st[1];
        if (nloc == 0u) { xcd_barrier_complete(bar, b.x, nloc, nx); b.st[0] = nloc; b.st[1] = nx; }
        const unsigned old = xb_add(&bar[XB_XSUB(b.x)], 1u);
        const unsigned gen = old / nloc;
        if (old + 1u == (gen + 1u) * nloc) {
            __builtin_amdgcn_fence(__ATOMIC_RELEASE, "agent");
            asm volatile("s_waitcnt vmcnt(0)" ::: "memory");
            const unsigned og = xb_add(&bar[XB_TOP], 1u);
            const unsigned tg = og / nx;
            if (og + 1u == (tg + 1u) * nx) xb_add(&bar[XB_TOPGEN], 1u);
            else XB_SPIN(xb_ld(&bar[XB_TOPGEN]) == tg, bar);
            __builtin_amdgcn_fence(__ATOMIC_ACQUIRE, "agent");
            xb_add(&bar[XB_XGEN(b.x)], 1u);
            asm volatile("s_waitcnt vmcnt(0)" ::: "memory");
        } else {
            XB_SPIN(xb_ld(&bar[XB_XGEN(b.x)]) == gen, bar);
            __builtin_amdgcn_fence(__ATOMIC_ACQUIRE, "agent");
            asm volatile("s_waitcnt vmcnt(0)" ::: "memory");
        }
    }
    __syncthreads();
}

struct Frame {
    LAS unsigned char* lds;
    volatile LAS unsigned* MISC;
    gu32* ctl;
    int tid, lane, wave, vcu, G;
    const float *x, *mem, *norm_g, *w_in, *conv_w, *a_log, *dt_bias, *gdn_ng, *i_bias, *f_bias, *ml_ng, *mem_ng, *w_kv, *w_out, *fin_g;
    float* out;
    bf16 *XN, *WIN, *WOUT, *KV, *KM, *VT, *PROJ, *HALO;
    unsigned char* CHK; float* GSC; float* STML; unsigned char* STGD;
    float* GATES;
};

DI int win_old_col(int n) {
    if (n < 2304) return n;
    if (n < 5376) return n + 12;
    if (n < NP) return n + 24;
    const int c = n - NP;
    if (c < 12) return 2304 + c;
    if (c < 24) return 5388 + (c - 12);
    return -1;
}
DI void p0_transpose_item(const float* W, int K, int Nold, bf16* WT, int nblk, int mode, LAS float* scr, int item, int lane) {
    const int kb = item / nblk, nb = item % nblk, k0 = 64 * kb, n0 = 32 * nb;
    const int nn = n0 + (lane & 31);
    const int oc = mode ? win_old_col(nn) : nn;
#pragma unroll 8
    for (int i = 0; i < 32; ++i) { const int kk = 2 * i + (lane >> 5); scr[kk * 33 + (lane & 31)] = oc >= 0 ? W[(size_t)(k0 + kk) * Nold + oc] : 0.f; }
    LDS_WAIT(); asm volatile("" ::: "memory");
    const int c = lane & 7;
#pragma unroll
    for (int j = 0; j < 4; ++j) { const int n = (lane >> 3) + 8 * j; const LAS float* s = scr + (8 * c) * 33 + n;
        v4u o; o.x = pk2(s[0 * 33], s[1 * 33]); o.y = pk2(s[2 * 33], s[3 * 33]); o.z = pk2(s[4 * 33], s[5 * 33]); o.w = pk2(s[6 * 33], s[7 * 33]);
        *(GAS v4u*)(WT + (size_t)(n0 + n) * K + k0 + 8 * c) = o; }
    LDS_WAIT(); asm volatile("" ::: "memory");
}
DI void rms_row_to_bf16(int lane, const float* xrow, const float* g, bf16* orow) {
    const GAS f32x4* xr = (const GAS f32x4*)xrow + lane; const GAS f32x4* gr = (const GAS f32x4*)g + lane;
    f32x4 v[4]; float s = 0.f;
#pragma unroll
    for (int j = 0; j < 4; ++j) { v[j] = xr[64 * j]; s += (v[j].x * v[j].x + v[j].y * v[j].y) + (v[j].z * v[j].z + v[j].w * v[j].w); }
    const float rstd = 1.f / sqrtf(wave_sum(s) * (1.f / DM) + EPS);
    GAS unsigned long long* o8 = (GAS unsigned long long*)orow + lane;
#pragma unroll
    for (int j = 0; j < 4; ++j) { const f32x4 gg = gr[64 * j];
        o8[64 * j] = (unsigned long long)pk2(v[j].x * rstd * gg.x, v[j].y * rstd * gg.y) | ((unsigned long long)pk2(v[j].z * rstd * gg.z, v[j].w * rstd * gg.w) << 32); }
}
DI void p0_prologue(Frame& F) {
    LAS float* scr = (LAS float*)(F.lds + RING_OFF + F.wave * 16384);
    const int gw = F.vcu * NWAVES + F.wave, NGW = F.G * NWAVES;
    constexpr int I_IN = (DM / 64) * (NG / 32), I_KV = (DM / 64) * (NKV / 32), I_OUT = (KOUT / 64) * (DM / 32);
    for (int it = gw; it < I_IN + I_KV + I_OUT; it += NGW) {
        int r = it;
        if (r < I_IN) { p0_transpose_item(F.w_in, DM, IN_COLS, F.WIN, NG / 32, 1, scr, r, F.lane); continue; } r -= I_IN;
        if (r < I_KV) { p0_transpose_item(F.w_kv, DM, NKV, F.WIN + (size_t)NG * DM, NKV / 32, 0, scr, r, F.lane); continue; } r -= I_KV;
        p0_transpose_item(F.w_out, KOUT, DM, F.WOUT, DM / 32, 0, scr, r, F.lane);
    }
    for (int m = gw; m < MTOK + MMEM; m += NGW) {
        if (m < MTOK) rms_row_to_bf16(F.lane, F.x + (size_t)m * DM, F.norm_g, F.XN + (size_t)m * DM);
        else rms_row_to_bf16(F.lane, F.mem + (size_t)(m - MTOK) * DM, F.mem_ng, F.XN + (size_t)m * DM);
    }
}

template <class ACol, class Epi>
DI void gemm_ref_tile(Frame& F, const bf16* A, int lda, const bf16* Bt, int ldb, int m0, int n0, int K, const ACol& acol, const Epi& E) {
    LAS float* As = (LAS float*)(F.lds + RING_OFF);
    LAS float* Bs = As + 16 * 132;
    const int tid = F.tid, tx = tid & 15, ty = tid >> 4;
    float acc[4][8];
#pragma unroll
    for (int r = 0; r < 4; ++r)
#pragma unroll
        for (int c = 0; c < 8; ++c) acc[r][c] = 0.f;
    const int lrow = (tid & 255) >> 1, lch = tid & 1;
    for (int k0 = 0; k0 < K; k0 += 16) {
        v4u v;
        if (tid < 256) v = *(const GAS v4u*)(A + (size_t)(m0 + lrow) * lda + acol(k0) + lch * 8);
        else v = *(const GAS v4u*)(Bt + (size_t)(n0 + lrow) * ldb + k0 + lch * 8);
        __syncthreads();
        LAS float* dst = (tid < 256 ? As : Bs) + (lch * 8) * 132 + lrow;
        dst[0 * 132] = bflo(v.x); dst[1 * 132] = bfhi(v.x); dst[2 * 132] = bflo(v.y); dst[3 * 132] = bfhi(v.y);
        dst[4 * 132] = bflo(v.z); dst[5 * 132] = bfhi(v.z); dst[6 * 132] = bflo(v.w); dst[7 * 132] = bfhi(v.w);
        __syncthreads();
#pragma unroll 4
        for (int k = 0; k < 16; ++k) {
            const f32x4 a = *(const LAS f32x4*)(As + k * 132 + ty * 4);
            const f32x4 b0 = *(const LAS f32x4*)(Bs + k * 132 + tx * 8), b1 = *(const LAS f32x4*)(Bs + k * 132 + tx * 8 + 4);
#pragma unroll
            for (int r = 0; r < 4; ++r) {
                acc[r][0] += a[r] * b0.x; acc[r][1] += a[r] * b0.y; acc[r][2] += a[r] * b0.z; acc[r][3] += a[r] * b0.w;
                acc[r][4] += a[r] * b1.x; acc[r][5] += a[r] * b1.y; acc[r][6] += a[r] * b1.z; acc[r][7] += a[r] * b1.w; }
        }
    }
#pragma unroll
    for (int r = 0; r < 4; ++r) E(m0 + ty * 4 + r, n0 + tx * 8, acc[r]);
    __syncthreads();
}
struct AColId { DI int operator()(int k) const { return k; } };
struct AColMix { DI int operator()(int k) const { return k < 768 ? C_GV + k : (k < 1536 ? C_MV + (k - 768) : C_XQ + (k - 1536)); } };

DI float gate_transform(const Frame& F, int c, float v) {
    const int kind = c / 6, h = c - kind * 6;
    if (kind == 0) return -__expf(F.a_log[h]) * softplusf_(v + F.dt_bias[h]);
    if (kind == 1) return sigmoidf_(v);
    if (kind == 2) return v + F.i_bias[h];
    return -softplusf_(-(v + F.f_bias[h]));
}
struct EpiProjRef {
    const Frame* F;
    DI void operator()(int m, int n, const float (&v)[8]) const {
        if (m < MTOK) {
            if (n < NP) { v4u o; o.x = pk2(v[0], v[1]); o.y = pk2(v[2], v[3]); o.z = pk2(v[4], v[5]); o.w = pk2(v[6], v[7]); *(GAS v4u*)(F->PROJ + (size_t)m * NP + n) = o; }
            else {
#pragma unroll
                for (int j = 0; j < 8; ++j) { const int c = n - NP + j; if (c < 24) F->GATES[(size_t)m * 32 + c] = v[j]; }
            }
        } else {
            v4u o; o.x = pk2(v[0], v[1]); o.y = pk2(v[2], v[3]); o.z = pk2(v[4], v[5]); o.w = pk2(v[6], v[7]);
            *(GAS v4u*)(F->KV + (size_t)(m - MTOK) * NKV + (n - NG)) = o;
        }
    }
};
struct EpiOutRef {
    const Frame* F;
    DI void operator()(int m, int n, const float (&v)[8]) const {
        const GAS f32x4* xr = (const GAS f32x4*)(F->x + (size_t)m * DM + n);
        const f32x4 x0 = xr[0], x1 = xr[1];
        GAS f32x4* o = (GAS f32x4*)(F->out + (size_t)m * DM + n);
        o[0] = (f32x4){x0.x + v[0], x0.y + v[1], x0.z + v[2], x0.w + v[3]};
        o[1] = (f32x4){x1.x + v[4], x1.y + v[5], x1.z + v[6], x1.w + v[7]};
    }
};
DI void p1_gemm_in_ref(Frame& F) {
    constexpr int T1 = (MTOK / 128) * (NG / 128), T2 = (MMEM / 128) * (NKV / 128);
    EpiProjRef E{&F};
    for (int L = F.vcu; L < T1 + T2; L += F.G) {
        int m0, n0;
        if (L < T1) { m0 = (L / (NG / 128)) * 128; n0 = (L % (NG / 128)) * 128; }
        else { const int r = L - T1; m0 = MTOK + (r / (NKV / 128)) * 128; n0 = NG + (r % (NKV / 128)) * 128; }
        gemm_ref_tile(F, F.XN, DM, F.WIN, DM, m0, n0, DM, AColId{}, E);
    }
}
DI void p3_gemm_out_ref(Frame& F) {
    constexpr int T1 = (MTOK / 128) * (DM / 128);
    EpiOutRef E{&F};
    for (int L = F.vcu; L < T1; L += F.G) {
        const int m0 = (L / (DM / 128)) * 128, n0 = (L % (DM / 128)) * 128;
        gemm_ref_tile(F, F.PROJ, NP, F.WOUT, KOUT, m0, n0, KOUT, AColMix{}, E);
    }
}
DI void p4_final_norm(Frame& F) {
    const int gw = F.vcu * NWAVES + F.wave, NGW = F.G * NWAVES;
    for (int m = gw; m < MTOK; m += NGW) {
        GAS f32x4* yr = (GAS f32x4*)(F.out + (size_t)m * DM) + F.lane; const GAS f32x4* gr = (const GAS f32x4*)F.fin_g + F.lane;
        f32x4 v[4]; float s = 0.f;
#pragma unroll
        for (int j = 0; j < 4; ++j) { v[j] = yr[64 * j]; s += (v[j].x * v[j].x + v[j].y * v[j].y) + (v[j].z * v[j].z + v[j].w * v[j].w); }
        const float rstd = 1.f / sqrtf(wave_sum(s) * (1.f / DM) + EPS);
#pragma unroll
        for (int j = 0; j < 4; ++j) { const f32x4 gg = gr[64 * j]; yr[64 * j] = (f32x4){v[j].x * rstd * gg.x, v[j].y * rstd * gg.y, v[j].z * rstd * gg.z, v[j].w * rstd * gg.w}; }
    }
}

namespace pg8 {
#define PG8_LAS __attribute__((address_space(3)))
typedef unsigned short bf16_t;
typedef short bf16x8 __attribute__((ext_vector_type(8)));
typedef float f32x4 __attribute__((ext_vector_type(4)));
typedef unsigned u32x4 __attribute__((ext_vector_type(4)));
constexpr int BM = 256, BK = 64, HALF = 128, HTB = HALF * BK * 2, STAGE_BYTES = 8 * HTB, NXCD = 8, WGM = 8;
__host__ __device__ __forceinline__ int lds_byte(int r, int c) { const int st = (r >> 4) * 2 + (c >> 5), rr = r & 15, cc = c & 31, ob = rr * 64 + cc * 2; return st * 1024 + (ob ^ (((ob >> 9) & 1) << 5)); }
__host__ __device__ __forceinline__ void stage_rc(int b, int& R, int& C) { const int st = b / 1024, sb = b % 1024, swz = sb ^ (((sb >> 9) & 1) << 5); R = (st >> 1) * 16 + swz / 64; C = (st & 1) * 32 + (swz % 64) / 2; }
__host__ __device__ __forceinline__ int perm32(int rho) { const int n = rho >> 4, i = rho & 15; return 8 * (i >> 2) + 4 * n + (i & 3); }
struct Unit { int pm, pn; };
struct Gemm { const bf16_t* A; const bf16_t* Bt; int K, lda, ldb; };
__host__ __device__ __forceinline__ void tile_of(int L, int nM, int nN, Unit& u) {
    const int nwg = nM * nN; int wgid = L;
    { const int q = nwg / NXCD, r = nwg % NXCD, xcd = wgid % NXCD, off = wgid / NXCD; wgid = (xcd < r ? xcd * (q + 1) : r * (q + 1) + (xcd - r) * q) + off; }
    const int nig = WGM * nN, gid = wgid / nig, fm = gid * WGM, gsz = (nM - fm) < WGM ? (nM - fm) : WGM;
    u.pm = fm + ((wgid % nig) % gsz); u.pn = (wgid % nig) / gsz;
}
struct StaticOrder {
    int nM, nN, nwg, G, c;
    __host__ __device__ void init(int M, int N, int G_, int c_) { nM = M / BM; nN = N / BM; nwg = nM * nN; G = G_; c = c_; }
    __host__ __device__ bool next(int i, Unit& u) const { const long L = (long)i * G + c; if (L >= nwg) return false; tile_of((int)L, nM, nN, u); return true; }
    __device__ __forceinline__ void a_ready(const Unit&) const {}
    __device__ __forceinline__ void done(const Unit&) const {}
};
__device__ __forceinline__ unsigned cvt_pk_bf16(float lo, float hi) { unsigned r; asm volatile("v_cvt_pk_bf16_f32 %0, %1, %2" : "=v"(r) : "v"(lo), "v"(hi)); return r; }
struct AMapId { __device__ __forceinline__ size_t operator()(int t) const { return (size_t)t * (BK * 2); } };

template <class Epi, class Sched, class AMap, bool ALIGN_EPI>
__device__ __forceinline__ void gemm_phase(PG8_LAS unsigned char* lds, const Gemm g, const Sched& S, const Epi& E, const AMap& AM) {
    const int tid = threadIdx.x, wid = __builtin_amdgcn_readfirstlane(tid >> 6), lane = tid & 63, wr = wid >> 2, wc = wid & 3, fr = lane & 15, fq = lane >> 4;
    const int K = g.K, nt = K / BK;
    unsigned voffA[2], voffB[2];
#pragma unroll
    for (int i = 0; i < 2; ++i) { int R, C; stage_rc(tid * 16 + i * 8192, R, C); const int Rb = Epi::PERM ? ((R & ~31) + perm32(R & 31)) : R;
        voffA[i] = (unsigned)(R * g.lda + C) * 2u; voffB[i] = (unsigned)(Rb * g.ldb + C) * 2u; }
    const size_t kstep = (size_t)(BK * 2);
    const size_t hstepA = (size_t)HALF * g.lda * 2, hstepB = (size_t)HALF * g.ldb * 2;
    const size_t tstepA = 2 * hstepA, tstepB = 2 * hstepB;
    const unsigned ldsw = (unsigned)wid * 1024u;
    const int aoff = lds_byte(wr * 64 + fr, fq * 8), boff = lds_byte(wc * 32 + fr, fq * 8);
#define PG8_SA(b, h) (((b) * 2 + (h)) * HTB)
#define PG8_SB(b, h) ((4 + (b) * 2 + (h)) * HTB)
#define PG8_STAGE(bufoff, gbase, voff) do { _Pragma("unroll") for (int _i = 0; _i < 2; ++_i) \
        __builtin_amdgcn_global_load_lds((const unsigned*)((const char*)(gbase) + (voff)[_i]), (PG8_LAS unsigned*)(lds + (bufoff) + ldsw + _i * 8192), 16, 0, 0); } while (0)
#define PG8_LDA(dst, b, h) do { _Pragma("unroll") for (int m = 0; m < 4; ++m) _Pragma("unroll") for (int k = 0; k < 2; ++k) dst[m][k] = *(const PG8_LAS bf16x8*)(lds + PG8_SA(b, h) + aoff + m * 2048 + k * 1024); } while (0)
#define PG8_LDB(dst, b, h) do { _Pragma("unroll") for (int n = 0; n < 2; ++n) _Pragma("unroll") for (int k = 0; k < 2; ++k) dst[n][k] = *(const PG8_LAS bf16x8*)(lds + PG8_SB(b, h) + boff + n * 2048 + k * 1024); } while (0)
#define PG8_MMA(ai, bj, At, Bt) do { __builtin_amdgcn_s_setprio(1); _Pragma("unroll") for (int m = 0; m < 4; ++m) _Pragma("unroll") for (int n = 0; n < 2; ++n) _Pragma("unroll") for (int k = 0; k < 2; ++k) \
        acc[ai][bj][m][n] = __builtin_amdgcn_mfma_f32_16x16x32_bf16(Bt[n][k], At[m][k], acc[ai][bj][m][n], 0, 0, 0); __builtin_amdgcn_s_setprio(0); } while (0)
#define PG8_WAIT_V(n) asm volatile("s_waitcnt vmcnt(" #n ")" ::: "memory")
#define PG8_WAIT_L(n) asm volatile("s_waitcnt lgkmcnt(" #n ")" ::: "memory")
#define PG8_BAR __builtin_amdgcn_s_barrier()
#define PG8_SCHED __builtin_amdgcn_sched_barrier(0)
    Unit cur, nxt; int ui = 0;
    if (!S.next(0, cur)) return;
    f32x4 acc[2][2][4][2];
#pragma unroll
    for (int a = 0; a < 2; ++a)
#pragma unroll
        for (int b = 0; b < 2; ++b)
#pragma unroll
            for (int m = 0; m < 4; ++m)
#pragma unroll
                for (int n = 0; n < 2; ++n) acc[a][b][m][n] = (f32x4){0.f, 0.f, 0.f, 0.f};
    bf16x8 At[4][2], B0[2][2], B1[2][2];
    const char* cA = (const char*)g.A + (size_t)cur.pm * tstepA; const char* cB = (const char*)g.Bt + (size_t)cur.pn * tstepB;
    S.a_ready(cur);
    PG8_STAGE(PG8_SB(0, 0), cB, voffB); PG8_STAGE(PG8_SB(0, 1), cB + hstepB, voffB); PG8_STAGE(PG8_SA(0, 0), cA + AM(0), voffA); PG8_STAGE(PG8_SA(0, 1), cA + AM(0) + hstepA, voffA);
    if (wr == 1) PG8_BAR;
    PG8_WAIT_V(2); PG8_BAR;
    PG8_STAGE(PG8_SB(1, 0), cB + kstep, voffB); PG8_STAGE(PG8_SA(1, 0), cA + AM(1), voffA); PG8_STAGE(PG8_SB(1, 1), cB + hstepB + kstep, voffB);
    PG8_WAIT_V(6); PG8_BAR;
    for (;;) {
        const bool has_next = S.next(ui + 1, nxt);
        const char* nA = has_next ? (const char*)g.A + (size_t)nxt.pm * tstepA : cA; const char* nB = has_next ? (const char*)g.Bt + (size_t)nxt.pn * tstepB : cB;
        for (int t = 0; t < nt; t += 2) {
            const bool last = (t == nt - 2);
            const char* a1 = cA + AM(t + 1);
            const char* a2 = last ? nA + AM(0) : cA + AM(t + 2); const char* b2 = last ? nB : cB + (size_t)(t + 2) * kstep;
            const char* a3 = last ? nA + AM(1) : cA + AM(t + 3); const char* b3 = b2 + kstep;
            if (last && has_next) S.a_ready(nxt);
            PG8_LDB(B0, 0, 0); PG8_LDB(B1, 0, 1); PG8_SCHED; PG8_LDA(At, 0, 0); PG8_STAGE(PG8_SA(1, 1), a1 + hstepA, voffA);
            PG8_WAIT_V(8); PG8_WAIT_L(0); PG8_BAR; PG8_MMA(0, 0, At, B0); PG8_MMA(0, 1, At, B1); PG8_BAR; PG8_SCHED;
            PG8_LDA(At, 0, 1); PG8_STAGE(PG8_SB(0, 0), b2, voffB); PG8_STAGE(PG8_SB(0, 1), b2 + hstepB, voffB); PG8_STAGE(PG8_SA(0, 0), a2, voffA);
            PG8_WAIT_V(8); PG8_WAIT_L(0); PG8_BAR; PG8_MMA(1, 0, At, B0); PG8_MMA(1, 1, At, B1); PG8_BAR; PG8_SCHED;
            PG8_LDB(B0, 1, 0); PG8_LDB(B1, 1, 1); PG8_SCHED; PG8_LDA(At, 1, 0); PG8_STAGE(PG8_SA(0, 1), a2 + hstepA, voffA);
            PG8_WAIT_V(8); PG8_WAIT_L(0); PG8_BAR; PG8_MMA(0, 0, At, B0); PG8_MMA(0, 1, At, B1); PG8_BAR; PG8_SCHED;
            PG8_LDA(At, 1, 1); PG8_STAGE(PG8_SB(1, 0), b3, voffB); PG8_STAGE(PG8_SB(1, 1), b3 + hstepB, voffB); PG8_STAGE(PG8_SA(1, 0), a3, voffA);
            PG8_WAIT_V(8); PG8_WAIT_L(0); PG8_BAR; PG8_MMA(1, 0, At, B0); PG8_MMA(1, 1, At, B1); PG8_BAR; PG8_SCHED;
        }
        if constexpr (ALIGN_EPI) { if (wr == 0) PG8_BAR; }
        if constexpr (!Epi::AFTER_DRAIN) { E(acc, cur, wr, wc, fr, fq); S.done(cur); }
        if (!has_next) break;
#pragma unroll
        for (int a = 0; a < 2; ++a)
#pragma unroll
            for (int b = 0; b < 2; ++b)
#pragma unroll
                for (int m = 0; m < 4; ++m)
#pragma unroll
                    for (int n = 0; n < 2; ++n) acc[a][b][m][n] = (f32x4){0.f, 0.f, 0.f, 0.f};
        cur = nxt; cA = nA; cB = nB; ++ui;
        if constexpr (ALIGN_EPI) { if (wr == 1) PG8_BAR; }
    }
    PG8_WAIT_V(0);
    if constexpr (!ALIGN_EPI) { if (wr == 0) PG8_BAR; }
    PG8_BAR;
    if constexpr (Epi::AFTER_DRAIN) { E.fused(acc, cur, wr, wc, fr, fq, lds, wid, lane); S.done(cur); }
#undef PG8_SA
#undef PG8_SB
#undef PG8_STAGE
#undef PG8_LDA
#undef PG8_LDB
#undef PG8_MMA
#undef PG8_WAIT_V
#undef PG8_WAIT_L
#undef PG8_BAR
#undef PG8_SCHED
}
}

constexpr int ZT_WIN = (MTOK + MMEM) / 256, ZT_MEM = MTOK / 256, ZT_WK = ZT_WIN + NG / 256, ZT_WV = ZT_WK + 2;
struct OrderIn {
    int G, c;
    __device__ __forceinline__ bool next(int i, pg8::Unit& u) const {
        const long L = (long)i * G + c;
        if (L < 4096) { pg8::tile_of((int)L, MTOK / 256, NG / 256, u); u.pn += ZT_WIN; return true; }
        const int r = (int)L - 4096; if (r >= 32) return false;
        if (r < 16) { u.pm = ZT_MEM + (r >> 1); u.pn = ZT_WK + (r & 1); } else { u.pm = ZT_WV + ((r - 16) >> 3); u.pn = ZT_MEM + ((r - 16) & 7); }
        return true;
    }
    __device__ __forceinline__ void a_ready(const pg8::Unit&) const {}
    __device__ __forceinline__ void done(const pg8::Unit&) const {}
};
struct EpiProj {
    static constexpr bool PERM = true, AFTER_DRAIN = false;
    const Frame* F;
    __device__ __forceinline__ void operator()(const pg8::f32x4 (&acc)[2][2][4][2], const pg8::Unit& u, int wr, int wc, int fr, int fq) const {
        const int row0 = u.pm * 256 + wr * 64 + fr, colt = wc * 32 + 8 * fq;
        if (u.pm < ZT_MEM && u.pn == ZT_WIN + NP / 256) {
            if (wc == 0 && fq < 3) {
#pragma unroll
                for (int ai = 0; ai < 2; ++ai)
#pragma unroll
                    for (int m = 0; m < 4; ++m) { float* gp = F->GATES + (size_t)(row0 + ai * 128 + m * 16) * 32 + 8 * fq;
                        *(pg8::f32x4*)gp = acc[ai][0][m][0]; *(pg8::f32x4*)(gp + 4) = acc[ai][0][m][1]; }
            }
            return;
        }
        bf16* base; int ldc;
        if (u.pm < ZT_MEM && u.pn < ZT_WIN + 9 && fr >= 13) {
#pragma unroll
            for (int ai = 0; ai < 2; ++ai) { const int rowg = row0 + ai * 128 + 48;
                bf16* hp = F->HALO + ((size_t)(rowg >> 6) * 3 + (fr - 13)) * 2304 + (size_t)(u.pn - ZT_WIN) * 256 + colt;
#pragma unroll
                for (int bj = 0; bj < 2; ++bj) { const pg8::f32x4 v0 = acc[ai][bj][3][0], v1 = acc[ai][bj][3][1];
                    v4u w; w.x = pg8::cvt_pk_bf16(v0[0], v0[1]); w.y = pg8::cvt_pk_bf16(v0[2], v0[3]); w.z = pg8::cvt_pk_bf16(v1[0], v1[1]); w.w = pg8::cvt_pk_bf16(v1[2], v1[3]);
                    *(v4u*)(hp + bj * 128) = w; } }
        }
        if (u.pm < ZT_MEM) { base = F->PROJ + (size_t)(u.pn - ZT_WIN) * 256; ldc = NP; }
        else if (u.pm < ZT_WIN) { base = F->KM - (size_t)MTOK * 512 + (size_t)(u.pn - ZT_WK) * 256; ldc = 512; }
        else { base = F->VT - (size_t)(ZT_WV * 256) * MMEM + (size_t)(u.pn - ZT_MEM) * 256; ldc = MMEM; }
#pragma unroll
        for (int ai = 0; ai < 2; ++ai)
#pragma unroll
            for (int m = 0; m < 4; ++m) { bf16* rowp = base + (size_t)(row0 + ai * 128 + m * 16) * ldc + colt;
#pragma unroll
                for (int bj = 0; bj < 2; ++bj) { const pg8::f32x4 v0 = acc[ai][bj][m][0], v1 = acc[ai][bj][m][1];
                    v4u w; w.x = pg8::cvt_pk_bf16(v0[0], v0[1]); w.y = pg8::cvt_pk_bf16(v0[2], v0[3]); w.z = pg8::cvt_pk_bf16(v1[0], v1[1]); w.w = pg8::cvt_pk_bf16(v1[2], v1[3]);
                    *(v4u*)(rowp + bj * 128) = w; } }
    }
};
struct AMapMix { __device__ __forceinline__ size_t operator()(int t) const { const int k = t * 64; return (size_t)(k < 768 ? C_GV + k : (k < 1536 ? C_MV + (k - 768) : C_XQ + (k - 1536))) * 2; } };
struct EpiOut {
    static constexpr bool PERM = false, AFTER_DRAIN = false;
    const float* x; float* out;
    __device__ __forceinline__ void operator()(const pg8::f32x4 (&acc)[2][2][4][2], const pg8::Unit& u, int wr, int wc, int fr, int fq) const {
        const int row0 = u.pm * 256 + wr * 64 + fr, col0 = u.pn * 256 + wc * 32 + 4 * fq;
#pragma unroll
        for (int ai = 0; ai < 2; ++ai)
#pragma unroll
            for (int m = 0; m < 4; ++m) { const size_t off = (size_t)(row0 + ai * 128 + m * 16) * DM + col0;
#pragma unroll
                for (int bj = 0; bj < 2; ++bj)
#pragma unroll
                    for (int n = 0; n < 2; ++n) { const pg8::f32x4 xv = *(const pg8::f32x4*)(x + off + bj * 128 + n * 16); *(pg8::f32x4*)(out + off + bj * 128 + n * 16) = xv + acc[ai][bj][m][n]; } }
    }
};
DI void p1_gemm_in(Frame& F) {
    pg8::Gemm g{F.XN, F.XN, DM, DM, DM}; OrderIn S{F.G, (int)blockIdx.x}; EpiProj E{&F};
    pg8::gemm_phase<EpiProj, OrderIn, pg8::AMapId, true>(F.lds + RING_OFF, g, S, E, pg8::AMapId{});
}
DI void p3_gemm_out(Frame& F) {
    pg8::Gemm g{F.PROJ, F.WOUT, KOUT, NP, KOUT}; pg8::StaticOrder S; S.init(MTOK, DM, F.G, (int)blockIdx.x); EpiOut E{F.x, F.out};
    pg8::gemm_phase<EpiOut, pg8::StaticOrder, AMapMix, true>(F.lds + RING_OFF, g, S, E, AMapMix{});
}

DI void gdn_ref_item(Frame& F, int item) {
    const int b = item / 6, h = item % 6, tid = F.tid, lane = F.lane, wave = F.wave;
    LAS float* QKV = (LAS float*)(F.lds + RING_OFF);
    LAS float* OB = (LAS float*)(F.lds + RING_OFF + 98304);
    LAS bf16* HALOV = (LAS bf16*)(F.lds + XTRA_OFF);
    LAS float* AT = (LAS float*)(F.lds + XTRA_OFF + 768);
    LAS float* BT = AT + 64;
    float S[128];
#pragma unroll
    for (int d = 0; d < 128; ++d) S[d] = 0.f;
    for (int c = 0; c < NCH; ++c) {
        const int m0 = b * SEQ + c * CH;
#pragma unroll 2
        for (int i = 0; i < 48; ++i) {
            const int idx = tid + NTHR * i, t = idx / 384, cc = idx - t * 384, seg = cc >> 7, d = cc & 127;
            QKV[t * 384 + cc] = bf2f(F.PROJ[(size_t)(m0 + t) * NP + seg * 768 + h * 128 + d]);
        }
        if (tid < 64) { AT[tid] = __expf(gate_transform(F, h, F.GATES[(size_t)(m0 + tid) * 32 + h])); BT[tid] = gate_transform(F, 6 + h, F.GATES[(size_t)(m0 + tid) * 32 + 6 + h]); }
        __syncthreads();
        if (tid < 128) {
            const int e = tid;
#pragma unroll 1
            for (int t = 0; t < CH; ++t) {
                const LAS float* q = QKV + t * 384; const LAS float* k = q + 128;
                const float a = AT[t], be = BT[t], v = q[256 + e];
                float r = 0.f;
#pragma unroll
                for (int db = 0; db < 128; db += 16) {
#pragma unroll
                    for (int d = 0; d < 16; ++d) r += k[db + d] * S[db + d];
                    asm volatile("" ::: "memory");
                }
                const float vn = be * (v - a * r);
                float o = 0.f;
#pragma unroll
                for (int db = 0; db < 128; db += 16) {
#pragma unroll
                    for (int d = 0; d < 16; ++d) { S[db + d] = a * S[db + d] + k[db + d] * vn; o += q[db + d] * S[db + d]; }
                    asm volatile("" ::: "memory");
                }
                OB[t * 128 + e] = o;
            }
        }
        __syncthreads();
#pragma unroll 1
        for (int i = 0; i < 8; ++i) {
            const int t = wave + 8 * i;
            const float o0 = OB[t * 128 + lane], o1 = OB[t * 128 + 64 + lane];
            const float rstd = 1.f / sqrtf(wave_sum(o0 * o0 + o1 * o1) * (1.f / 128.f) + EPS);
            const size_t row = (size_t)(m0 + t) * NP;
            const float z0 = bf2f(F.PROJ[row + C_GZ + h * 128 + lane]), z1 = bf2f(F.PROJ[row + C_GZ + h * 128 + 64 + lane]);
            F.PROJ[row + C_GV + h * 128 + lane] = (bf16)f2bf(o0 * rstd * F.gdn_ng[lane] * siluf_(z0));
            F.PROJ[row + C_GV + h * 128 + 64 + lane] = (bf16)f2bf(o1 * rstd * F.gdn_ng[64 + lane] * siluf_(z1));
        }
        __syncthreads();
    }
}
DI void mlstm_ref_item(Frame& F, int item) {
    const int b = item / 6, h = item % 6, tid = F.tid, lane = F.lane, wave = F.wave;
    LAS float* QKV = (LAS float*)(F.lds + RING_OFF);
    LAS float* NUM = (LAS float*)(F.lds + RING_OFF + 98304);
    LAS float* FT = (LAS float*)(F.lds + XTRA_OFF);
    LAS float* IT = FT + 64;
    LAS float* DEN = IT + 64;
    float C[128];
#pragma unroll
    for (int d = 0; d < 128; ++d) C[d] = 0.f;
    float n0 = 0.f, n1 = 0.f;
    for (int c = 0; c < NCH; ++c) {
        const int m0 = b * SEQ + c * CH;
#pragma unroll 2
        for (int i = 0; i < 48; ++i) {
            const int idx = tid + NTHR * i, t = idx / 384, cc = idx - t * 384, seg = cc >> 7, d = cc & 127;
            float v = bf2f(F.PROJ[(size_t)(m0 + t) * NP + C_MQ + seg * 768 + h * 128 + d]);
            if (seg == 1) v *= RSQRT_HD;
            QKV[t * 384 + cc] = v;
        }
        if (tid < 64) { FT[tid] = __expf(gate_transform(F, 18 + h, F.GATES[(size_t)(m0 + tid) * 32 + 18 + h])); IT[tid] = __expf(gate_transform(F, 12 + h, F.GATES[(size_t)(m0 + tid) * 32 + 12 + h])); }
        __syncthreads();
        if (tid < 128) {
            const int e = tid;
#pragma unroll 1
            for (int t = 0; t < CH; ++t) {
                const LAS float* q = QKV + t * 384; const LAS float* k = q + 128;
                const float f = FT[t], iv = IT[t] * q[256 + e];
                float num = 0.f;
#pragma unroll
                for (int db = 0; db < 128; db += 16) {
#pragma unroll
                    for (int d = 0; d < 16; ++d) { C[db + d] = f * C[db + d] + iv * k[db + d]; num += q[db + d] * C[db + d]; }
                    asm volatile("" ::: "memory");
                }
                NUM[t * 128 + e] = num;
            }
        } else if (tid < 192) {
#pragma unroll 1
            for (int t = 0; t < CH; ++t) {
                const LAS float* q = QKV + t * 384; const LAS float* k = q + 128;
                const float f = FT[t], ig = IT[t];
                n0 = f * n0 + ig * k[lane]; n1 = f * n1 + ig * k[lane + 64];
                const float den = wave_sum(q[lane] * n0 + q[lane + 64] * n1);
                if (lane == 0) DEN[t] = den;
            }
        }
        __syncthreads();
#pragma unroll 1
        for (int i = 0; i < 8; ++i) {
            const int t = wave + 8 * i;
            const size_t row = (size_t)(m0 + t) * NP;
            const float dn = 1.f / fmaxf(fabsf(DEN[t]), 1.f);
            const float g0 = sigmoidf_(bf2f(F.PROJ[row + C_MO + h * 128 + lane])), g1 = sigmoidf_(bf2f(F.PROJ[row + C_MO + h * 128 + 64 + lane]));
            const float h0 = NUM[t * 128 + lane] * dn * g0, h1 = NUM[t * 128 + 64 + lane] * dn * g1;
            const float rstd = 1.f / sqrtf(wave_sum(h0 * h0 + h1 * h1) * (1.f / 128.f) + EPS);
            const float z0 = bf2f(F.PROJ[row + C_MZ + h * 128 + lane]), z1 = bf2f(F.PROJ[row + C_MZ + h * 128 + 64 + lane]);
            F.PROJ[row + C_MV + h * 128 + lane] = (bf16)f2bf(h0 * rstd * F.ml_ng[h * 128 + lane] * siluf_(z0));
            F.PROJ[row + C_MV + h * 128 + 64 + lane] = (bf16)f2bf(h1 * rstd * F.ml_ng[h * 128 + 64 + lane] * siluf_(z1));
        }
        __syncthreads();
    }
}
typedef short bf16x8 __attribute__((ext_vector_type(8)));
typedef __bf16 bf2_t __attribute__((ext_vector_type(2)));
typedef float f2_t __attribute__((ext_vector_type(2)));
DI unsigned cvt_pk_bf16(float lo, float hi) { return __builtin_bit_cast(unsigned, __builtin_convertvector((f2_t){lo, hi}, bf2_t)); }
DI unsigned cvt_pk_bf16_asm(float lo, float hi) { unsigned r; asm volatile("v_cvt_pk_bf16_f32 %0, %1, %2" : "=v"(r) : "v"(lo), "v"(hi)); return r; }
DI bf16x8 pack8_asm(const f32x4 a, const f32x4 b) { v4u p; p.x = cvt_pk_bf16_asm(a[0], a[1]); p.y = cvt_pk_bf16_asm(a[2], a[3]); p.z = cvt_pk_bf16_asm(b[0], b[1]); p.w = cvt_pk_bf16_asm(b[2], b[3]); return __builtin_bit_cast(bf16x8, p); }
DI bf16x8 pack8(const f32x4 a, const f32x4 b) { v4u p; p.x = cvt_pk_bf16(a[0], a[1]); p.y = cvt_pk_bf16(a[2], a[3]); p.z = cvt_pk_bf16(b[0], b[1]); p.w = cvt_pk_bf16(b[2], b[3]); return __builtin_bit_cast(bf16x8, p); }
#define MFMA16(a, b, c) __builtin_amdgcn_mfma_f32_16x16x32_bf16((a), (b), (c), 0, 0, 0)
DI void xattn_item(Frame& F, int item) {
    const int tt = item & 15, h = (item >> 4) & 3, b = item >> 6, tid0_ = F.tid, lane0_ = F.lane, wave = F.wave;
    int tid = tid0_, lane = lane0_; asm volatile("" : "+v"(tid), "+v"(lane));
    const int lr = lane & 15, g = lane >> 4;
    LAS unsigned char* Kimg = F.lds + RING_OFF;
    LAS unsigned char* Vimg = F.lds + RING_OFF + 65536;
    __syncthreads();
#pragma unroll 2
    for (int i = 0; i < 8; ++i) {
        const int idx = tid + NTHR * i;
        { const int r = idx >> 4, ch = idx & 15;
          const v4u v = *(const GAS v4u*)(F.KM + (size_t)(b * NMEM + r) * 512 + h * 128 + ch * 8);
          *(LAS v4u*)(Kimg + r * 256 + ((ch ^ (r & 15)) << 4)) = v; }
        { const int r = idx >> 5, ch = idx & 31;
          const v4u v = *(const GAS v4u*)(F.VT + (size_t)(h * 128 + r) * MMEM + b * NMEM + ch * 8);
          *(LAS v4u*)(Vimg + r * 512 + ((ch ^ (r & 15)) << 4)) = v; }
    }
    __syncthreads();
#pragma unroll 1
    for (int p = 0; p < 2; ++p) {
        const int t0 = tt * 256 + wave * 32 + p * 16;
        const size_t row = (size_t)(b * SEQ + t0 + lr) * NP;
        bf16x8 qf[4];
#pragma unroll
        for (int ks = 0; ks < 4; ++ks) qf[ks] = *(const GAS bf16x8*)(F.PROJ + row + C_XQ + h * 128 + 32 * ks + 8 * g);
        f32x4 st[16];
#pragma unroll
        for (int mt = 0; mt < 16; ++mt) {
            const int j = 32 * (mt >> 1) + 8 * (lr >> 2) + 4 * (mt & 1) + (lr & 3);
            f32x4 acc = {0.f, 0.f, 0.f, 0.f};
#pragma unroll
            for (int ks = 0; ks < 4; ++ks) {
                const bf16x8 a = *(const LAS bf16x8*)(Kimg + j * 256 + (((4 * ks + g) ^ (j & 15)) << 4));
                acc = MFMA16(a, qf[ks], acc);
            }
            st[mt] = acc;
        }
        float mx = -3.0e38f;
#pragma unroll
        for (int mt = 0; mt < 16; ++mt) mx = fmaxf(mx, fmaxf(fmaxf(st[mt][0], st[mt][1]), fmaxf(st[mt][2], st[mt][3])));
        mx = fmaxf(mx, __shfl_xor(mx, 16)); mx = fmaxf(mx, __shfl_xor(mx, 32));
        float l = 0.f;
#pragma unroll
        for (int mt = 0; mt < 16; ++mt)
#pragma unroll
            for (int r = 0; r < 4; ++r) { const float pv = __expf((st[mt][r] - mx) * RSQRT_HD); st[mt][r] = pv; l += pv; }
        l += __shfl_xor(l, 16); l += __shfl_xor(l, 32);
        const float il = 1.f / l;
        bf16x8 pb[8];
#pragma unroll
        for (int ks = 0; ks < 8; ++ks) pb[ks] = pack8_asm(st[2 * ks], st[2 * ks + 1]);
#pragma unroll
        for (int dt = 0; dt < 8; ++dt) {
            const int d = 16 * dt + lr;
            f32x4 o = {0.f, 0.f, 0.f, 0.f};
#pragma unroll
            for (int ks = 0; ks < 8; ++ks) {
                const bf16x8 a = *(const LAS bf16x8*)(Vimg + d * 512 + (((4 * ks + g) ^ (d & 15)) << 4));
                o = MFMA16(a, pb[ks], o);
            }
            const int dc = h * 128 + 16 * dt + 4 * g;
            const v2u zz = *(const GAS v2u*)(F.PROJ + row + C_XZ + dc);
            v2u w; w.x = pk2(o[0] * il * siluf_(bflo(zz.x)), o[1] * il * siluf_(bfhi(zz.x))); w.y = pk2(o[2] * il * siluf_(bflo(zz.y)), o[3] * il * siluf_(bfhi(zz.y)));
            *(GAS v2u*)(F.PROJ + row + C_XQ + dc) = w;
        }
    }
}
typedef short s16x4 __attribute__((ext_vector_type(4)));
DI unsigned img_off(int row, int ch) { return 272u * (unsigned)row + 16u * (unsigned)ch; }
DI unsigned sq_off(int row, int ch) { return 144u * (unsigned)row + 16u * (unsigned)ch; }
DI bf16x8 row_frag(const LAS unsigned char* img, int row, int ks, int g) { return *(const LAS bf16x8*)(img + img_off(row, 4 * ks + g)); }
DI bf16x8 tr_frag(LAS unsigned char* img, int row0, int col0, int lane) {
    const int i = lane & 15, g = lane >> 4, r0 = row0 + 8 * g + (i >> 2), c = col0 + 4 * (i & 3);
    const s16x4 a = __builtin_amdgcn_ds_read_tr16_b64_v4i16((LAS s16x4*)(img + img_off(r0, c >> 3) + (c & 4) * 2));
    const s16x4 b = __builtin_amdgcn_ds_read_tr16_b64_v4i16((LAS s16x4*)(img + img_off(r0 + 4, c >> 3) + (c & 4) * 2));
    return (bf16x8){a[0], a[1], a[2], a[3], b[0], b[1], b[2], b[3]};
}
DI float fexp(float x) { return __builtin_amdgcn_exp2f(x * 1.4426950408889634f); }
DI float frcp(float x) { return __builtin_amdgcn_rcpf(x); }
DI float fsilu(float x) { return x * frcp(1.f + fexp(-x)); }
DI float fsigmoid(float x) { return frcp(1.f + fexp(-x)); }
DI float row_sum16(float x) {
    x += __builtin_bit_cast(float, __builtin_amdgcn_update_dpp(0, __builtin_bit_cast(int, x), 0x128, 0xf, 0xf, false));
    x += __builtin_bit_cast(float, __builtin_amdgcn_update_dpp(0, __builtin_bit_cast(int, x), 0x124, 0xf, 0xf, false));
    x += __builtin_bit_cast(float, __builtin_amdgcn_update_dpp(0, __builtin_bit_cast(int, x), 0x122, 0xf, 0xf, false));
    x += __builtin_bit_cast(float, __builtin_amdgcn_update_dpp(0, __builtin_bit_cast(int, x), 0x121, 0xf, 0xf, false));
    return x;
}
DI float sum_rows4(float x) { x += __shfl_xor(x, 16); x += __shfl_xor(x, 32); return x; }
DI void lds_add(LAS float* p, float v) { (void)__hip_atomic_fetch_add(p, v, __ATOMIC_RELAXED, __HIP_MEMORY_SCOPE_WORKGROUP); }
DI float wave_incl_sum(float x, int lane) {
#pragma unroll
    for (int o = 1; o < 64; o <<= 1) { const float y = __shfl_up(x, o); if (lane >= o) x += y; }
    return x;
}
DI float wave_incl_max(float x, int lane) {
#pragma unroll
    for (int o = 1; o < 64; o <<= 1) { const float y = __shfl_up(x, o); if (lane >= o) x = fmaxf(x, y); }
    return x;
}

constexpr int ML_Q = 0, ML_K = 17408, ML_KE = 34816, ML_V = 52224, ML_P = 69632, ML_ARR = 78848;
DI void mlstm_item(Frame& F, int item) {
    const int seg = item % NSEG, bh = item / NSEG, b = bh / 6, h = bh % 6, tid0_ = F.tid, lane0_ = F.lane, w = F.wave, lr0_ = lane0_ & 15, g0_ = lane0_ >> 4;
    int tid = tid0_, lane = lane0_; asm volatile("" : "+v"(tid), "+v"(lane));
    const int lr = lane & 15, g = lane >> 4; (void)lr0_; (void)g0_;
    const int c0 = seg * SEGC, c1 = c0 + SEGC;
    const float* slot = F.STML + (size_t)item * ST_ML;
    LAS unsigned char* Qi = F.lds + RING_OFF + ML_Q; LAS unsigned char* Ki = F.lds + RING_OFF + ML_K; LAS unsigned char* KEi = F.lds + RING_OFF + ML_KE;
    LAS unsigned char* Vi = F.lds + RING_OFF + ML_V; LAS unsigned char* Pi = F.lds + RING_OFF + ML_P;
    LAS float* GA = (LAS float*)(F.lds + RING_OFF + ML_ARR); LAS float* GPM = GA + 128; LAS float* GBC = GPM + 128;
    LAS float* DEN1 = GBC + 128; LAS float* DEN2 = DEN1 + 128; LAS float* SS = DEN2 + 64; LAS float* NV = SS + 128;
    f32x4 Cw[8];
#pragma unroll
    for (int i = 0; i < 8; ++i) Cw[i] = *(const GAS f32x4*)(slot + ((w * 8 + i) * 64 + lane) * 4);
    float m_st = slot[16514];
    __syncthreads();
    if (tid < 128) { NV[tid] = slot[16384 + tid]; DEN1[tid] = 0.f; SS[tid] = 0.f; }
    v4u pre[6], gpre; float ga2, ga3, m63n;
    const f32x4 gn = *(const GAS f32x4*)(F.ml_ng + h * 128 + 16 * w + 4 * g);
    bf16x8 ones; { const short o1 = (short)0x3F80;
#pragma unroll
        for (int i = 0; i < 8; ++i) ones[i] = o1; }
#define ML_LOAD(c_) do { const size_t m0_ = (size_t)(b * SEQ + (c_) * CH); _Pragma("unroll") for (int i = 0; i < 6; ++i) { const int idx = tid + NTHR * i, mat = idx >> 10, r = (idx >> 4) & 63, ch = idx & 15; \
        pre[i] = *(const GAS v4u*)(F.PROJ + (m0_ + r) * NP + C_MQ + mat * 768 + h * 128 + ch * 8); } \
        const float* gs_ = F.GSC + (size_t)((b * NCH + (c_)) * 6 + h) * 448 + 256; \
        ga2 = gs_[((tid + NTHR * 2) >> 4) & 63]; ga3 = gs_[((tid + NTHR * 3) >> 4) & 63]; m63n = gs_[64 + 63]; \
        if (tid < 48) gpre = *(const GAS v4u*)(gs_ + tid * 4); } while (0)
#define ML_WRITE(c_, mst_) do { const int p_ = ((c_) & 1) * 64; const float M63_ = m63n; const float sl_ = fexp(M63_ - fmaxf((mst_), M63_)) * RSQRT_HD; \
        if (tid < 48) { const int a_ = tid >> 4, o_ = (tid & 15) * 4; *(LAS v4u*)((a_ == 0 ? GA : (a_ == 1 ? GPM : GBC)) + p_ + o_) = gpre; } \
        _Pragma("unroll") for (int i = 0; i < 6; ++i) { const int idx = tid + NTHR * i, mat = idx >> 10, r = (idx >> 4) & 63, ch = idx & 15; \
            if (mat == 0) *(LAS v4u*)(Qi + img_off(r, ch)) = pre[i]; \
            else if (mat == 2) *(LAS v4u*)(Vi + img_off(r, ch)) = pre[i]; \
            else { *(LAS v4u*)(Ki + img_off(r, ch)) = pre[i]; \
                const float wk = fexp((i == 2 ? ga2 : ga3) - M63_) * sl_; \
                v2u lo, hi; lo.x = cvt_pk_bf16(bflo(pre[i].x) * wk, bfhi(pre[i].x) * wk); lo.y = cvt_pk_bf16(bflo(pre[i].y) * wk, bfhi(pre[i].y) * wk); \
                hi.x = cvt_pk_bf16(bflo(pre[i].z) * wk, bfhi(pre[i].z) * wk); hi.y = cvt_pk_bf16(bflo(pre[i].w) * wk, bfhi(pre[i].w) * wk); \
                const int a_ = ch >> 2, b_ = ch & 3; \
                *(LAS v2u*)(KEi + img_off(r, 4 * a_ + (b_ >> 1)) + (b_ & 1) * 8) = lo;            \
                *(LAS v2u*)(KEi + img_off(r, 4 * a_ + 2 + (b_ >> 1)) + (b_ & 1) * 8) = hi; }     \
        } } while (0)
    ML_LOAD(c0);
    ML_WRITE(c0, m_st);
    __syncthreads();
#pragma unroll 1
    for (int c = c0; c < c1; ++c) {
        const int p = (c & 1) * 64;
        const size_t m0 = (size_t)(b * SEQ + c * CH);
        const float M63 = GPM[p + 63], blast = GBC[p + 63], Mx = fmaxf(m_st, M63), s_old = fexp(m_st - Mx);
        if (c + 1 < c1) { ML_LOAD(c + 1); }
        v2u mo_[4], mz_[4];
#pragma unroll
        for (int tt = 0; tt < 4; ++tt) { mo_[tt] = *(const GAS v2u*)(F.PROJ + (m0 + 16 * tt + lr) * NP + C_MO + h * 128 + 16 * w + 4 * g); mz_[tt] = *(const GAS v2u*)(F.PROJ + (m0 + 16 * tt + lr) * NP + C_MZ + h * 128 + 16 * w + 4 * g); }
        if (tid < 64) { DEN1[(p ^ 64) + tid] = 0.f; SS[(p ^ 64) + tid] = 0.f; }
        {
            const int t = tid >> 3, part = tid & 7;
            const v4u q0 = *(const LAS v4u*)(Qi + img_off(t, 2 * part)), q1 = *(const LAS v4u*)(Qi + img_off(t, 2 * part + 1));
            const LAS f32x4* nv = (const LAS f32x4*)(NV + 16 * part);
            const f32x4 n0 = nv[0], n1 = nv[1], n2 = nv[2], n3 = nv[3];
            float s = bflo(q0.x) * n0[0] + bfhi(q0.x) * n0[1] + bflo(q0.y) * n0[2] + bfhi(q0.y) * n0[3] + bflo(q0.z) * n1[0] + bfhi(q0.z) * n1[1] + bflo(q0.w) * n1[2] + bfhi(q0.w) * n1[3]
                    + bflo(q1.x) * n2[0] + bfhi(q1.x) * n2[1] + bflo(q1.y) * n2[2] + bfhi(q1.y) * n2[3] + bflo(q1.z) * n3[0] + bfhi(q1.z) * n3[1] + bflo(q1.w) * n3[2] + bfhi(q1.w) * n3[3];
            s += __builtin_bit_cast(float, __builtin_amdgcn_update_dpp(0, __builtin_bit_cast(int, s), 0xB1, 0xf, 0xf, false));
            s += __builtin_bit_cast(float, __builtin_amdgcn_update_dpp(0, __builtin_bit_cast(int, s), 0x4E, 0xf, 0xf, false));
            s += __shfl_xor(s, 4);
            if (part == 0) DEN2[t] = s;
        }
        {
            const int tt = w >> 1, t = 16 * tt + lr;
            const float pmt = GPM[p + t];
#pragma unroll
            for (int j = 0; j < 2; ++j) {
                const int st = 2 * (w & 1) + j;
                f32x4 acc = {0.f, 0.f, 0.f, 0.f};
                if (st <= tt) {
#pragma unroll
                    for (int ks = 0; ks < 4; ++ks) acc = MFMA16(row_frag(Ki, 16 * st + lr, ks, g), row_frag(Qi, t, ks, g), acc);
                }
                const f32x4 ga4 = *(const LAS f32x4*)(GA + p + 16 * st + 4 * g);
                float pv[4], ps = 0.f;
#pragma unroll
                for (int r = 0; r < 4; ++r) { const int s = 16 * st + 4 * g + r; pv[r] = (s <= t) ? fexp(ga4[r] - pmt) * RSQRT_HD * acc[r] : 0.f; ps += pv[r]; }
                if (st <= tt) { ps = sum_rows4(ps); if (g == 0) lds_add(DEN1 + p + t, ps); }
                v2u o; o.x = cvt_pk_bf16(pv[0], pv[1]); o.y = cvt_pk_bf16(pv[2], pv[3]);
                *(LAS v2u*)(Pi + sq_off(t, 2 * st + (g >> 1)) + (g & 1) * 8) = o;
            }
        }
        __syncthreads();
        f32x4 x1[4], x2[4];
        {
            bf16x8 vf[2], pc[4];
#pragma unroll
            for (int ks = 0; ks < 2; ++ks) vf[ks] = tr_frag(Vi, 32 * ks, 16 * w, lane);
#pragma unroll
            for (int ks = 0; ks < 4; ++ks) pc[ks] = pack8(Cw[2 * ks], Cw[2 * ks + 1]);
#pragma unroll
            for (int tt = 0; tt < 4; ++tt) {
                const int t = 16 * tt + lr;
                f32x4 a1 = {0.f, 0.f, 0.f, 0.f}, a2 = {0.f, 0.f, 0.f, 0.f};
#pragma unroll
                for (int ks = 0; ks < 2; ++ks) { const bf16x8 pf = *(const LAS bf16x8*)(Pi + sq_off(t, 4 * ks + g)); a1 = MFMA16(vf[ks], pf, a1); }
#pragma unroll
                for (int ks = 0; ks < 4; ++ks) a2 = MFMA16(pc[ks], row_frag(Qi, t, ks, g), a2);
                x1[tt] = a1; x2[tt] = a2;
                asm volatile("" ::: "memory");
            }
#pragma unroll
            for (int dt = 0; dt < 8; ++dt) Cw[dt] = Cw[dt] * s_old;
            f32x4 ninc = {0.f, 0.f, 0.f, 0.f};
#pragma unroll
            for (int dt = 0; dt < 8; ++dt) {
#pragma unroll
                for (int ks = 0; ks < 2; ++ks) { const bf16x8 kf = tr_frag(KEi, 32 * ks, 16 * dt, lane); Cw[dt] = MFMA16(kf, vf[ks], Cw[dt]); if (dt == w) ninc = MFMA16(ones, kf, ninc); }
                if (dt & 1) asm volatile("" ::: "memory");
            }
            if (g == 0) { const int d = 32 * (w >> 1) + 8 * (lr >> 2) + 4 * (w & 1) + (lr & 3); NV[d] = s_old * NV[d] + ninc[0]; }
        }
        float hv[4][4];
#pragma unroll
        for (int tt = 0; tt < 4; ++tt) {
            const int t = 16 * tt + lr;
            const float pmt = GPM[p + t], Mt = fmaxf(m_st, pmt), At = fexp(m_st - Mt), Rt = fexp(pmt - Mt), em = fexp(-(GBC[p + t] + Mt));
            const float den = At * DEN2[t] + Rt * DEN1[p + t];
            const float idn = frcp(fmaxf(fabsf(den), em));
            const v2u mo = mo_[tt];
            const float a_ = At * idn, r_ = Rt * idn;
            hv[tt][0] = (a_ * x2[tt][0] + r_ * x1[tt][0]) * fsigmoid(bflo(mo.x)); hv[tt][1] = (a_ * x2[tt][1] + r_ * x1[tt][1]) * fsigmoid(bfhi(mo.x));
            hv[tt][2] = (a_ * x2[tt][2] + r_ * x1[tt][2]) * fsigmoid(bflo(mo.y)); hv[tt][3] = (a_ * x2[tt][3] + r_ * x1[tt][3]) * fsigmoid(bfhi(mo.y));
            float ss = hv[tt][0] * hv[tt][0] + hv[tt][1] * hv[tt][1] + hv[tt][2] * hv[tt][2] + hv[tt][3] * hv[tt][3];
            ss = sum_rows4(ss);
            if (g == 0) lds_add(SS + p + t, ss);
        }
        __syncthreads();
#pragma unroll
        for (int tt = 0; tt < 4; ++tt) {
            const int t = 16 * tt + lr;
            const float rstd = __builtin_amdgcn_rsqf(SS[p + t] * (1.f / 128.f) + EPS);
            const v2u mz = mz_[tt];
            v2u o; o.x = cvt_pk_bf16(hv[tt][0] * rstd * gn[0] * fsilu(bflo(mz.x)), hv[tt][1] * rstd * gn[1] * fsilu(bfhi(mz.x)));
            o.y = cvt_pk_bf16(hv[tt][2] * rstd * gn[2] * fsilu(bflo(mz.y)), hv[tt][3] * rstd * gn[3] * fsilu(bfhi(mz.y)));
            *(GAS v2u*)(F.PROJ + (m0 + t) * NP + C_MV + h * 128 + 16 * w + 4 * g) = o;
        }
        m_st = blast + Mx;
        if (c + 1 < c1) ML_WRITE(c + 1, m_st);
        __syncthreads();
    }
#undef ML_LOAD
#undef ML_WRITE
}
DI void mlstm_light(Frame& F, int item) {
    const int seg = item % NSEG, bh = item / NSEG, b = bh / 6, h = bh % 6, tid0_ = F.tid, lane0_ = F.lane, w = F.wave, lr0_ = lane0_ & 15, g0_ = lane0_ >> 4;
    int tid = tid0_, lane = lane0_; asm volatile("" : "+v"(tid), "+v"(lane));
    const int lr = lane & 15, g = lane >> 4; (void)lr0_; (void)g0_;
    const int c0 = seg * SEGC, c1 = c0 + SEGC;
    float* slot = F.STML + (size_t)item * ST_ML;
    LAS unsigned char* KEi = F.lds + RING_OFF; LAS unsigned char* Vi = F.lds + RING_OFF + 2 * 17408;
    LAS float* NV = (LAS float*)(F.lds + RING_OFF + 4 * 17408);
    f32x4 Cw[8];
#pragma unroll
    for (int i = 0; i < 8; ++i) Cw[i] = (f32x4){0.f, 0.f, 0.f, 0.f};
    float m_st = -1.0e30f, bseg = 0.f;
    __syncthreads();
    if (tid < 128) NV[tid] = 0.f;
    bf16x8 ones; { const short o1 = (short)0x3F80;
#pragma unroll
        for (int i = 0; i < 8; ++i) ones[i] = o1; }
    v4u pre[4]; float ga0, ga1, m63n, blastn;
#define MLL_LOAD(c_) do { const size_t m0_ = (size_t)(b * SEQ + (c_) * CH); _Pragma("unroll") for (int i = 0; i < 2; ++i) { const int idx = tid + NTHR * i, r = idx >> 4, ch = idx & 15; \
        pre[i] = *(const GAS v4u*)(F.PROJ + (m0_ + r) * NP + C_MK + h * 128 + ch * 8); pre[2 + i] = *(const GAS v4u*)(F.PROJ + (m0_ + r) * NP + C_MV + h * 128 + ch * 8); } \
        const float* gs_ = F.GSC + (size_t)((b * NCH + (c_)) * 6 + h) * 448 + 256; \
        ga0 = gs_[tid >> 4]; ga1 = gs_[(tid + NTHR) >> 4]; m63n = gs_[64 + 63]; blastn = gs_[128 + 63]; } while (0)
#define MLL_WRITE(c_, mst_) do { const int par_ = ((c_) & 1) * 17408; const float sl_ = fexp(m63n - fmaxf((mst_), m63n)) * RSQRT_HD; \
        _Pragma("unroll") for (int i = 0; i < 2; ++i) { const int idx = tid + NTHR * i, r = idx >> 4, ch = idx & 15; \
            *(LAS v4u*)(Vi + par_ + img_off(r, ch)) = pre[2 + i]; \
            const float wk = fexp((i == 0 ? ga0 : ga1) - m63n) * sl_; \
            v2u lo, hi; lo.x = cvt_pk_bf16(bflo(pre[i].x) * wk, bfhi(pre[i].x) * wk); lo.y = cvt_pk_bf16(bflo(pre[i].y) * wk, bfhi(pre[i].y) * wk); \
            hi.x = cvt_pk_bf16(bflo(pre[i].z) * wk, bfhi(pre[i].z) * wk); hi.y = cvt_pk_bf16(bflo(pre[i].w) * wk, bfhi(pre[i].w) * wk); \
            const int a_ = ch >> 2, b_ = ch & 3; \
            *(LAS v2u*)(KEi + par_ + img_off(r, 4 * a_ + (b_ >> 1)) + (b_ & 1) * 8) = lo; \
            *(LAS v2u*)(KEi + par_ + img_off(r, 4 * a_ + 2 + (b_ >> 1)) + (b_ & 1) * 8) = hi; } } while (0)
    MLL_LOAD(c0);
    MLL_WRITE(c0, m_st);
    float m63c = m63n, blastc = blastn;
    __syncthreads();
#pragma unroll 1
    for (int c = c0; c < c1; ++c) {
        const int par = (c & 1) * 17408;
        const float Mx = fmaxf(m_st, m63c), s_old = fexp(m_st - Mx);
        if (c + 1 < c1) { MLL_LOAD(c + 1); }
        {
            bf16x8 vf[2];
#pragma unroll
            for (int ks = 0; ks < 2; ++ks) vf[ks] = tr_frag(Vi + par, 32 * ks, 16 * w, lane);
#pragma unroll
            for (int dt = 0; dt < 8; ++dt) Cw[dt] = Cw[dt] * s_old;
            f32x4 ninc = {0.f, 0.f, 0.f, 0.f};
#pragma unroll
            for (int dt = 0; dt < 8; ++dt) {
#pragma unroll
                for (int ks = 0; ks < 2; ++ks) { const bf16x8 kf = tr_frag(KEi + par, 32 * ks, 16 * dt, lane); Cw[dt] = MFMA16(kf, vf[ks], Cw[dt]); if (dt == w) ninc = MFMA16(ones, kf, ninc); }
                if (dt & 1) asm volatile("" ::: "memory");
            }
            if (g == 0) { const int d = 32 * (w >> 1) + 8 * (lr >> 2) + 4 * (w & 1) + (lr & 3); NV[d] = s_old * NV[d] + ninc[0]; }
        }
        m_st = blastc + Mx; bseg += blastc;
        if (c + 1 < c1) { MLL_WRITE(c + 1, m_st); m63c = m63n; blastc = blastn; }
        __syncthreads();
    }
#pragma unroll
    for (int i = 0; i < 8; ++i) *(GAS f32x4*)(slot + ((w * 8 + i) * 64 + lane) * 4) = Cw[i];
    if (tid < 128) slot[16384 + tid] = NV[tid];
    if (tid == 0) { slot[16512] = m_st; slot[16513] = bseg; }
#undef MLL_LOAD
#undef MLL_WRITE
}
DI void mlstm_combine(Frame& F, int bh) {
    const int tid = F.tid, lane = F.lane, w = F.wave;
    f32x4 C[8];
#pragma unroll
    for (int i = 0; i < 8; ++i) C[i] = (f32x4){0.f, 0.f, 0.f, 0.f};
    float nreg = 0.f, m = 0.f;
#pragma unroll 1
    for (int j = 0; j < NSEG; ++j) {
        float* sl = F.STML + (size_t)(bh * NSEG + j) * ST_ML;
        f32x4 Cl[8];
#pragma unroll
        for (int i = 0; i < 8; ++i) Cl[i] = *(const GAS f32x4*)(sl + ((w * 8 + i) * 64 + lane) * 4);
        const float nl = tid < 128 ? sl[16384 + tid] : 0.f, ml = sl[16512], Bs = sl[16513];
#pragma unroll
        for (int i = 0; i < 8; ++i) *(GAS f32x4*)(sl + ((w * 8 + i) * 64 + lane) * 4) = C[i];
        if (tid < 128) sl[16384 + tid] = nreg;
        if (tid == 0) sl[16514] = m;
        const float me = fmaxf(Bs + m, ml), a = __expf(Bs + m - me), q = __expf(ml - me);
#pragma unroll
        for (int i = 0; i < 8; ++i) C[i] = C[i] * a + Cl[i] * q;
        nreg = a * nreg + q * nl; m = me;
    }
}

constexpr size_t CHK_STRIDE = 18432, CHK_NA = 0, CHK_ATT = 8192, CHK_DI = 16384;
constexpr int GD_Q = 0, GD_K = 17408, GD_V = 34816, GD_NA = 52224, GD_AT = 61440, GD_DI = 70656, GD_ARR = 72704, GD_Z = 75776, GD_ZB = 17408, GD_O = 110592;
DI bf16x8 row_frag_perm(const LAS unsigned char* img, int row, int ks, int g) {
    const v2u lo = *(const LAS v2u*)(img + img_off(row, 4 * ks + (g >> 1)) + (g & 1) * 8), hi = *(const LAS v2u*)(img + img_off(row, 4 * ks + 2 + (g >> 1)) + (g & 1) * 8);
    return __builtin_bit_cast(bf16x8, (v4u){lo.x, lo.y, hi.x, hi.y});
}
DI bf16x8 sq_frag_perm(const LAS unsigned char* img, int row, int ks, int g) {
    const v2u lo = *(const LAS v2u*)(img + sq_off(row, 4 * ks + (g >> 1)) + (g & 1) * 8), hi = *(const LAS v2u*)(img + sq_off(row, 4 * ks + 2 + (g >> 1)) + (g & 1) * 8);
    return __builtin_bit_cast(bf16x8, (v4u){lo.x, lo.y, hi.x, hi.y});
}
DI bf16x8 tr_frag_perm(LAS unsigned char* img, int row0, int col0, int lane) {
    const int i = lane & 15, g = lane >> 4, r0 = row0 + 4 * g + (i >> 2), c = col0 + 4 * (i & 3);
    const s16x4 a = __builtin_amdgcn_ds_read_tr16_b64_v4i16((LAS s16x4*)(img + img_off(r0, c >> 3) + (c & 4) * 2));
    const s16x4 b = __builtin_amdgcn_ds_read_tr16_b64_v4i16((LAS s16x4*)(img + img_off(r0 + 16, c >> 3) + (c & 4) * 2));
    return (bf16x8){a[0], a[1], a[2], a[3], b[0], b[1], b[2], b[3]};
}
constexpr size_t ST_GD = 98304;
DI void gdn_item(Frame& F, int item) {
    const int seg = item % NSEG, bh = item / NSEG, b = bh / 6, h = bh % 6, tid0_ = F.tid, lane0_ = F.lane, w = F.wave, lr0_ = lane0_ & 15, g0_ = lane0_ >> 4;
    int tid = tid0_, lane = lane0_; asm volatile("" : "+v"(tid), "+v"(lane));
    const int lr = lane & 15, g = lane >> 4; (void)lr0_; (void)g0_;
    const int c0 = seg * SEGC, c1 = c0 + SEGC;
    const float* slot = (const float*)(F.STGD + (size_t)item * ST_GD);
    LAS unsigned char* Qi = F.lds + RING_OFF + GD_Q; LAS unsigned char* Ki = F.lds + RING_OFF + GD_K; LAS unsigned char* Vi = F.lds + RING_OFF + GD_V;
    LAS unsigned char* NAi = F.lds + RING_OFF + GD_NA; LAS unsigned char* ATi = F.lds + RING_OFF + GD_AT; LAS unsigned char* DIi = F.lds + RING_OFF + GD_DI;
    LAS float* GB = (LAS float*)(F.lds + RING_OFF + GD_ARR);
    LAS float* SS = GB + 512;
    LAS unsigned char* Zi = F.lds + RING_OFF + GD_Z;
    LAS unsigned char* Oi = F.lds + RING_OFF + GD_O;
    f32x4 Sw[8];
#pragma unroll
    for (int i = 0; i < 8; ++i) Sw[i] = *(const GAS f32x4*)(slot + ((w * 8 + i) * 64 + lane) * 4);
    const float gn = F.gdn_ng[16 * w + lr];
    __syncthreads();
    if (tid < 128) SS[tid] = 0.f;
    v4u pre[11], gpre;
#define GD_LOAD(c_) do { const size_t m0_ = (size_t)(b * SEQ + (c_) * CH); const unsigned char* chk_ = F.CHK + (size_t)((b * NCH + (c_)) * 6 + h) * CHK_STRIDE; \
        _Pragma("unroll") for (int i = 0; i < 6; ++i) { const int idx = tid + NTHR * i, mat = idx >> 10, r = (idx >> 4) & 63, ch = idx & 15; \
            pre[i] = *(const GAS v4u*)(F.PROJ + (m0_ + r) * NP + mat * 768 + h * 128 + ch * 8); } \
        pre[6] = *(const GAS v4u*)(chk_ + (size_t)tid * 16); pre[7] = *(const GAS v4u*)(chk_ + (size_t)(tid + NTHR) * 16); \
        if (tid < 128) pre[8] = *(const GAS v4u*)(chk_ + CHK_DI + (size_t)tid * 16); \
        _Pragma("unroll") for (int i = 0; i < 2; ++i) { const int idx = tid + NTHR * i, r = idx >> 4, ch = idx & 15; pre[9 + i] = *(const GAS v4u*)(F.PROJ + (m0_ + r) * NP + C_GZ + h * 128 + ch * 8); } \
        if (tid < 64) gpre = *(const GAS v4u*)(F.GSC + (size_t)((b * NCH + (c_)) * 6 + h) * 448 + tid * 4); } while (0)
#define GD_WRITE(c_) do { \
        _Pragma("unroll") for (int i = 0; i < 2; ++i) { const int idx = tid + NTHR * i, r = idx >> 4, ch = idx & 15; *(LAS v4u*)(Zi + ((c_) & 1) * GD_ZB + img_off(r, ch)) = pre[9 + i]; } \
        if (tid < 64) *(LAS v4u*)(GB + ((c_) & 1) * 256 + tid * 4) = gpre; \
        _Pragma("unroll") for (int i = 0; i < 6; ++i) { const int idx = tid + NTHR * i, mat = idx >> 10, r = (idx >> 4) & 63, ch = idx & 15; \
            *(LAS v4u*)((mat == 0 ? Qi : (mat == 1 ? Ki : Vi)) + img_off(r, ch)) = pre[i]; } \
        { const int r = tid >> 3, ch = tid & 7; *(LAS v4u*)(NAi + sq_off(r, ch)) = pre[6]; *(LAS v4u*)(ATi + sq_off(r, ch)) = pre[7]; } \
        if (tid < 128) *(LAS v4u*)(DIi + tid * 16) = pre[8]; } while (0)
#define GD_STORE(c_) do { const size_t m0_ = (size_t)(b * SEQ + (c_) * CH); \
        _Pragma("unroll") for (int i = 0; i < 2; ++i) { const int idx = tid + NTHR * i, r = idx >> 4, ch = idx & 15; \
            *(GAS v4u*)(F.PROJ + (m0_ + r) * NP + C_GV + h * 128 + ch * 8) = *(const LAS v4u*)(Oi + img_off(r, ch)); } } while (0)
    GD_LOAD(c0);
    GD_WRITE(c0);
    __syncthreads();
#pragma unroll 1
    for (int c = c0; c < c1; ++c) {
        const int p = c & 1;
        const LAS float* BEa = GB + p * 256; const LAS float* BGa = BEa + 64; const LAS float* EGa = BEa + 128; const LAS float* EDa = BEa + 192;
        if (c > c0) GD_STORE(c - 1);
        if (c + 1 < c1) { GD_LOAD(c + 1); }
        if (tid < 64) SS[(p ^ 1) * 64 + tid] = 0.f;
        f32x4 ot[4], vn[4];
        {
            bf16x8 sp[4];
#pragma unroll
            for (int ks = 0; ks < 4; ++ks) sp[ks] = pack8(Sw[2 * ks], Sw[2 * ks + 1]);
#pragma unroll
            for (int st = 0; st < 4; ++st) {
                f32x4 ks_ = {0.f, 0.f, 0.f, 0.f}, qs_ = {0.f, 0.f, 0.f, 0.f};
#pragma unroll
                for (int ks = 0; ks < 4; ++ks) { ks_ = MFMA16(row_frag_perm(Ki, 16 * st + lr, ks, g), sp[ks], ks_); qs_ = MFMA16(row_frag_perm(Qi, 16 * st + lr, ks, g), sp[ks], qs_); }
                const f32x4 be4 = *(const LAS f32x4*)(BEa + 16 * st + 4 * g), bg4 = *(const LAS f32x4*)(BGa + 16 * st + 4 * g), eg4 = *(const LAS f32x4*)(EGa + 16 * st + 4 * g);
#pragma unroll
                for (int r = 0; r < 4; ++r) {
                    const int s = 16 * st + 4 * g + r, e = 16 * w + lr;
                    const float vv = bf2f(*(const LAS bf16*)(Vi + img_off(s, e >> 3) + (e & 7) * 2));
                    vn[st][r] = be4[r] * vv - bg4[r] * ks_[r];
                    ot[st][r] = qs_[r] * eg4[r];
                }
                asm volatile("" ::: "memory");
            }
            const v2u z2 = {0u, 0u};
            const v2u d0 = *(const LAS v2u*)(DIi + 0 * 512 + lr * 32 + g * 8), d1 = *(const LAS v2u*)(DIi + 1 * 512 + lr * 32 + g * 8);
            const v2u d2 = *(const LAS v2u*)(DIi + 2 * 512 + lr * 32 + g * 8), d3 = *(const LAS v2u*)(DIi + 3 * 512 + lr * 32 + g * 8);
            const bf16x8 di0 = __builtin_bit_cast(bf16x8, (v4u){d0.x, d0.y, z2.x, z2.y}), di1 = __builtin_bit_cast(bf16x8, (v4u){z2.x, z2.y, d1.x, d1.y});
            const bf16x8 di2 = __builtin_bit_cast(bf16x8, (v4u){d2.x, d2.y, z2.x, z2.y}), di3 = __builtin_bit_cast(bf16x8, (v4u){z2.x, z2.y, d3.x, d3.y});
            const bf16x8 na10 = sq_frag_perm(NAi, 16 + lr, 0, g), na20 = sq_frag_perm(NAi, 32 + lr, 0, g), na30 = sq_frag_perm(NAi, 48 + lr, 0, g), na31 = sq_frag_perm(NAi, 48 + lr, 1, g);
            const f32x4 zero4 = {0.f, 0.f, 0.f, 0.f};
            vn[0] = MFMA16(di0, pack8(vn[0], vn[1]), zero4);
            vn[1] = MFMA16(na10, pack8(vn[0], vn[1]), vn[1]);
            vn[1] = MFMA16(di1, pack8(vn[0], vn[1]), zero4);
            { const bf16x8 p01 = pack8(vn[0], vn[1]);
              vn[2] = MFMA16(na20, p01, vn[2]);
              vn[3] = MFMA16(na30, p01, vn[3]); }
            vn[2] = MFMA16(di2, pack8(vn[2], vn[3]), zero4);
            vn[3] = MFMA16(na31, pack8(vn[2], vn[3]), vn[3]);
            vn[3] = MFMA16(di3, pack8(vn[2], vn[3]), zero4);
            {
                const bf16x8 p01 = pack8(vn[0], vn[1]), p23 = pack8(vn[2], vn[3]);
#pragma unroll
                for (int tt = 0; tt < 4; ++tt) {
                    ot[tt] = MFMA16(sq_frag_perm(ATi, 16 * tt + lr, 0, g), p01, ot[tt]);
                    if (tt >= 2) ot[tt] = MFMA16(sq_frag_perm(ATi, 16 * tt + lr, 1, g), p23, ot[tt]);
                }
            }
            f32x4 vd[4];
#pragma unroll
            for (int st = 0; st < 4; ++st) vd[st] = vn[st] * *(const LAS f32x4*)(EDa + 16 * st + 4 * g);
            const bf16x8 q01 = pack8(vd[0], vd[1]), q23 = pack8(vd[2], vd[3]);
            const float egl = EGa[63];
#pragma unroll
            for (int dt = 0; dt < 8; ++dt) {
                Sw[dt] = Sw[dt] * egl;
                Sw[dt] = MFMA16(tr_frag_perm(Ki, 0, 16 * dt, lane), q01, Sw[dt]);
                Sw[dt] = MFMA16(tr_frag_perm(Ki, 32, 16 * dt, lane), q23, Sw[dt]);
                if (dt & 1) asm volatile("" ::: "memory");
            }
        }
        {
            float sq[4][4];
#pragma unroll
            for (int tt = 0; tt < 4; ++tt)
#pragma unroll
                for (int r = 0; r < 4; ++r) sq[tt][r] = row_sum16(ot[tt][r] * ot[tt][r]);
            if (lr == 0) {
#pragma unroll
                for (int tt = 0; tt < 4; ++tt)
#pragma unroll
                    for (int r = 0; r < 4; ++r) lds_add(SS + p * 64 + 16 * tt + 4 * g + r, sq[tt][r]);
            }
        }
        __syncthreads();
        {
            const int e = 16 * w + lr;
#pragma unroll
            for (int tt = 0; tt < 4; ++tt) {
                const f32x4 ss4 = *(const LAS f32x4*)(SS + p * 64 + 16 * tt + 4 * g);
#pragma unroll
                for (int r = 0; r < 4; ++r) {
                    const int t = 16 * tt + 4 * g + r;
                    const float rstd = __builtin_amdgcn_rsqf(ss4[r] * (1.f / 128.f) + EPS);
                    const float z = bf2f(*(const LAS bf16*)(Zi + p * GD_ZB + img_off(t, e >> 3) + (e & 7) * 2));
                    *(LAS bf16*)(Oi + img_off(t, e >> 3) + (e & 7) * 2) = (bf16)(cvt_pk_bf16(ot[tt][r] * rstd * gn * fsilu(z), 0.f) & 0xffffu);
                }
            }
        }
        if (c + 1 < c1) GD_WRITE(c + 1);
        __syncthreads();
    }
    GD_STORE(c1 - 1);
#undef GD_LOAD
#undef GD_WRITE
#undef GD_STORE
}
DI void gdn_light(Frame& F, int item) {
    const int seg = item % NSEG, bh = item / NSEG, b = bh / 6, h = bh % 6, tid0_ = F.tid, lane0_ = F.lane, w = F.wave, lr0_ = lane0_ & 15, g0_ = lane0_ >> 4;
    int tid = tid0_, lane = lane0_; asm volatile("" : "+v"(tid), "+v"(lane));
    const int lr = lane & 15, g = lane >> 4; (void)lr0_; (void)g0_;
    const int c0 = seg * SEGC, c1 = c0 + SEGC;
    unsigned char* slot = F.STGD + (size_t)item * ST_GD;
    constexpr int LB_ = 48128;
    f32x4 Sw[8], Mw[8];
#pragma unroll
    for (int i = 0; i < 8; ++i) { Sw[i] = (f32x4){0.f, 0.f, 0.f, 0.f};
#pragma unroll
        for (int r = 0; r < 4; ++r) Mw[i][r] = (16 * i + 4 * g + r == 16 * w + lr) ? 1.f : 0.f; }
    __syncthreads();
    v4u pre[6], gpre;
#define GL_LOAD(c_) do { const size_t m0_ = (size_t)(b * SEQ + (c_) * CH); const unsigned char* chk_ = F.CHK + (size_t)((b * NCH + (c_)) * 6 + h) * CHK_STRIDE; \
        _Pragma("unroll") for (int i = 0; i < 2; ++i) { const int idx = tid + NTHR * i, r = idx >> 4, ch = idx & 15; \
            pre[i] = *(const GAS v4u*)(F.PROJ + (m0_ + r) * NP + C_GK + h * 128 + ch * 8); pre[2 + i] = *(const GAS v4u*)(F.PROJ + (m0_ + r) * NP + C_GV + h * 128 + ch * 8); } \
        pre[4] = *(const GAS v4u*)(chk_ + (size_t)tid * 16); \
        if (tid < 128) pre[5] = *(const GAS v4u*)(chk_ + CHK_DI + (size_t)tid * 16); \
        if (tid < 64) gpre = *(const GAS v4u*)(F.GSC + (size_t)((b * NCH + (c_)) * 6 + h) * 448 + tid * 4); } while (0)
#define GL_WRITE(c_) do { LAS unsigned char* B_ = F.lds + RING_OFF + ((c_) & 1) * LB_; \
        _Pragma("unroll") for (int i = 0; i < 2; ++i) { const int idx = tid + NTHR * i, r = idx >> 4, ch = idx & 15; \
            *(LAS v4u*)(B_ + img_off(r, ch)) = pre[i]; *(LAS v4u*)(B_ + 17408 + img_off(r, ch)) = pre[2 + i]; } \
        { const int r = tid >> 3, ch = tid & 7; *(LAS v4u*)(B_ + 34816 + sq_off(r, ch)) = pre[4]; } \
        if (tid < 128) *(LAS v4u*)(B_ + 44032 + tid * 16) = pre[5]; \
        if (tid < 64) *(LAS v4u*)(B_ + 46080 + tid * 16) = gpre; } while (0)
    GL_LOAD(c0);
    GL_WRITE(c0);
    __syncthreads();
#pragma unroll 1
    for (int c = c0; c < c1; ++c) {
        LAS unsigned char* B = F.lds + RING_OFF + (c & 1) * LB_;
        LAS unsigned char* Ki = B; LAS unsigned char* Vi = B + 17408; LAS unsigned char* NAi = B + 34816; LAS unsigned char* DIi = B + 44032;
        const LAS float* BEa = (const LAS float*)(B + 46080); const LAS float* BGa = BEa + 64; const LAS float* EGa = BEa + 128; const LAS float* EDa = BEa + 192;
        if (c + 1 < c1) { GL_LOAD(c + 1); }
        {
            bf16x8 sp[4], mp[4];
#pragma unroll
            for (int ks = 0; ks < 4; ++ks) { sp[ks] = pack8(Sw[2 * ks], Sw[2 * ks + 1]); mp[ks] = pack8(Mw[2 * ks], Mw[2 * ks + 1]); }
            f32x4 vs[4], vm[4];
#pragma unroll
            for (int st = 0; st < 4; ++st) {
                f32x4 k1 = {0.f, 0.f, 0.f, 0.f}, k2 = {0.f, 0.f, 0.f, 0.f};
#pragma unroll
                for (int ks = 0; ks < 4; ++ks) { const bf16x8 kf = row_frag_perm(Ki, 16 * st + lr, ks, g); k1 = MFMA16(kf, sp[ks], k1); k2 = MFMA16(kf, mp[ks], k2); }
                const f32x4 be4 = *(const LAS f32x4*)(BEa + 16 * st + 4 * g), bg4 = *(const LAS f32x4*)(BGa + 16 * st + 4 * g);
#pragma unroll
                for (int r = 0; r < 4; ++r) {
                    const int s_ = 16 * st + 4 * g + r, e = 16 * w + lr;
                    const float vv = bf2f(*(const LAS bf16*)(Vi + img_off(s_, e >> 3) + (e & 7) * 2));
                    vs[st][r] = be4[r] * vv - bg4[r] * k1[r];
                    vm[st][r] = -bg4[r] * k2[r];
                }
                asm volatile("" ::: "memory");
            }
            const v2u z2 = {0u, 0u};
            const v2u d0 = *(const LAS v2u*)(DIi + 0 * 512 + lr * 32 + g * 8), d1 = *(const LAS v2u*)(DIi + 1 * 512 + lr * 32 + g * 8);
            const v2u d2 = *(const LAS v2u*)(DIi + 2 * 512 + lr * 32 + g * 8), d3 = *(const LAS v2u*)(DIi + 3 * 512 + lr * 32 + g * 8);
            const bf16x8 di0 = __builtin_bit_cast(bf16x8, (v4u){d0.x, d0.y, z2.x, z2.y}), di1 = __builtin_bit_cast(bf16x8, (v4u){z2.x, z2.y, d1.x, d1.y});
            const bf16x8 di2 = __builtin_bit_cast(bf16x8, (v4u){d2.x, d2.y, z2.x, z2.y}), di3 = __builtin_bit_cast(bf16x8, (v4u){z2.x, z2.y, d3.x, d3.y});
            const bf16x8 na10 = sq_frag_perm(NAi, 16 + lr, 0, g), na20 = sq_frag_perm(NAi, 32 + lr, 0, g), na30 = sq_frag_perm(NAi, 48 + lr, 0, g), na31 = sq_frag_perm(NAi, 48 + lr, 1, g);
            const f32x4 zero4 = {0.f, 0.f, 0.f, 0.f};
#define GL_SUBST(v) do { \
            v[0] = MFMA16(di0, pack8(v[0], v[1]), zero4); \
            v[1] = MFMA16(na10, pack8(v[0], v[1]), v[1]); \
            v[1] = MFMA16(di1, pack8(v[0], v[1]), zero4); \
            { const bf16x8 p01_ = pack8(v[0], v[1]); v[2] = MFMA16(na20, p01_, v[2]); v[3] = MFMA16(na30, p01_, v[3]); } \
            v[2] = MFMA16(di2, pack8(v[2], v[3]), zero4); \
            v[3] = MFMA16(na31, pack8(v[2], v[3]), v[3]); \
            v[3] = MFMA16(di3, pack8(v[2], v[3]), zero4); } while (0)
            GL_SUBST(vs);
            GL_SUBST(vm);
#undef GL_SUBST
#pragma unroll
            for (int st = 0; st < 4; ++st) { const f32x4 ed4 = *(const LAS f32x4*)(EDa + 16 * st + 4 * g); vs[st] = vs[st] * ed4; vm[st] = vm[st] * ed4; }
            const bf16x8 s01 = pack8(vs[0], vs[1]), s23 = pack8(vs[2], vs[3]), m01 = pack8(vm[0], vm[1]), m23 = pack8(vm[2], vm[3]);
            const float egl = EGa[63];
#pragma unroll
            for (int dt = 0; dt < 8; ++dt) {
                const bf16x8 t0 = tr_frag_perm(Ki, 0, 16 * dt, lane), t1 = tr_frag_perm(Ki, 32, 16 * dt, lane);
                Sw[dt] = Sw[dt] * egl; Mw[dt] = Mw[dt] * egl;
                Sw[dt] = MFMA16(t0, s01, Sw[dt]); Mw[dt] = MFMA16(t0, m01, Mw[dt]);
                Sw[dt] = MFMA16(t1, s23, Sw[dt]); Mw[dt] = MFMA16(t1, m23, Mw[dt]);
                if (dt & 1) asm volatile("" ::: "memory");
            }
        }
        if (c + 1 < c1) GL_WRITE(c + 1);
        __syncthreads();
    }
#pragma unroll
    for (int i = 0; i < 8; ++i) {
        *(GAS f32x4*)((float*)slot + ((w * 8 + i) * 64 + lane) * 4) = Sw[i];
        v2u o; o.x = cvt_pk_bf16(Mw[i][0], Mw[i][1]); o.y = cvt_pk_bf16(Mw[i][2], Mw[i][3]);
        *(GAS v2u*)(slot + 65536 + ((size_t)(16 * w + lr) * 128 + 16 * i + 4 * g) * 2) = o;
    }
#undef GL_LOAD
#undef GL_WRITE
}
DI void gdn_combine(Frame& F, int bh) {
    const int tid = F.tid, lane = F.lane, w = F.wave;
    LAS unsigned char* MT = F.lds + RING_OFF;
    f32x4 S[8];
#pragma unroll
    for (int i = 0; i < 8; ++i) S[i] = (f32x4){0.f, 0.f, 0.f, 0.f};
    __syncthreads();
#pragma unroll 1
    for (int j = 0; j < NSEG; ++j) {
        unsigned char* slot = F.STGD + (size_t)(bh * NSEG + j) * ST_GD;
        f32x4 Sl[8];
#pragma unroll
        for (int i = 0; i < 8; ++i) Sl[i] = *(const GAS f32x4*)((const float*)slot + ((w * 8 + i) * 64 + lane) * 4);
#pragma unroll
        for (int i = 0; i < 4; ++i) { const int idx = tid + NTHR * i, r = idx >> 4, ch = idx & 15; *(LAS v4u*)(MT + img_off(r, ch)) = *(const GAS v4u*)(slot + 65536 + (size_t)idx * 16); }
#pragma unroll
        for (int i = 0; i < 8; ++i) *(GAS f32x4*)((float*)slot + ((w * 8 + i) * 64 + lane) * 4) = S[i];
        __syncthreads();
        bf16x8 sp[4];
#pragma unroll
        for (int ks = 0; ks < 4; ++ks) sp[ks] = pack8(S[2 * ks], S[2 * ks + 1]);
#pragma unroll
        for (int mt = 0; mt < 8; ++mt) {
            f32x4 acc = Sl[mt];
#pragma unroll
            for (int ks = 0; ks < 4; ++ks) acc = MFMA16(tr_frag_perm(MT, 32 * ks, 16 * mt, lane), sp[ks], acc);
            S[mt] = acc;
        }
        __syncthreads();
    }
}

DI void gdn_prep_item(Frame& F, int item) {
    const int h = item % 6, bc = item / 6, c = bc & 63, b = bc >> 6, tid = F.tid;
    const int ch = tid & 15, rg = (tid >> 4) & 7, mat = tid >> 7;
    const size_t m0 = (size_t)(b * SEQ + c * CH);
    v4u ov[8];
    if (mat < 3) {
        const int col = mat * 768 + h * 128 + ch * 8;
        float wgt[4][8];
#pragma unroll
        for (int j = 0; j < 4; ++j) { const f32x4 w0 = *(const GAS f32x4*)(F.conv_w + j * 2304 + col), w1 = *(const GAS f32x4*)(F.conv_w + j * 2304 + col + 4);
            wgt[j][0] = w0[0]; wgt[j][1] = w0[1]; wgt[j][2] = w0[2]; wgt[j][3] = w0[3]; wgt[j][4] = w1[0]; wgt[j][5] = w1[1]; wgt[j][6] = w1[2]; wgt[j][7] = w1[3]; }
        v4u xr[11];
#pragma unroll
        for (int i = 0; i < 11; ++i) {
            const int r = 8 * rg - 3 + i;
            if (r >= 0) xr[i] = *(const GAS v4u*)(F.PROJ + (m0 + r) * NP + col);
            else if (c > 0) xr[i] = *(const GAS v4u*)(F.HALO + ((size_t)(b * 64 + c - 1) * 3 + (r + 3)) * 2304 + col);
            else xr[i] = (v4u){0u, 0u, 0u, 0u};
        }
        float y[8][8];
#pragma unroll
        for (int r = 0; r < 8; ++r)
#pragma unroll
            for (int e = 0; e < 8; ++e) y[r][e] = 0.f;
#pragma unroll
        for (int i = 0; i < 11; ++i) {
            const float xv[8] = {bflo(xr[i].x), bfhi(xr[i].x), bflo(xr[i].y), bfhi(xr[i].y), bflo(xr[i].z), bfhi(xr[i].z), bflo(xr[i].w), bfhi(xr[i].w)};
#pragma unroll
            for (int j = 0; j < 4; ++j) { const int r = i - j;
                if (r >= 0 && r < 8) {
#pragma unroll
                    for (int e = 0; e < 8; ++e) y[r][e] += wgt[j][e] * xv[e]; } }
        }
#pragma unroll
        for (int r = 0; r < 8; ++r) {
            float ss = 0.f;
#pragma unroll
            for (int e = 0; e < 8; ++e) { y[r][e] = siluf_(y[r][e]); ss += y[r][e] * y[r][e]; }
            float sc = 1.f;
            if (mat < 2) { ss += __shfl_xor(ss, 1); ss += __shfl_xor(ss, 2); ss += __shfl_xor(ss, 4); ss += __shfl_xor(ss, 8); sc = (1.f / sqrtf(ss + EPS)) * (mat == 0 ? RSQRT_HD : 1.f); }
            ov[r].x = pk2(y[r][0] * sc, y[r][1] * sc); ov[r].y = pk2(y[r][2] * sc, y[r][3] * sc); ov[r].z = pk2(y[r][4] * sc, y[r][5] * sc); ov[r].w = pk2(y[r][6] * sc, y[r][7] * sc);
        }
    }
    LAS unsigned char* Qi = F.lds + RING_OFF; LAS unsigned char* Ki = F.lds + RING_OFF + 17408;
    LAS float* LB = (LAS float*)(F.lds + RING_OFF + 34816);
    LAS float* GC = LB + 1024; LAS float* BE = GC + 64;
    if (mat < 2) {
#pragma unroll
        for (int r = 0; r < 8; ++r) *(LAS v4u*)((mat == 0 ? Qi : Ki) + img_off(8 * rg + r, ch)) = ov[r];
    }
    if (F.wave == 7) {
        const float gl = gate_transform(F, h, F.GATES[(m0 + F.lane) * 32 + h]);
        const float gc = wave_incl_sum(gl, F.lane), be = gate_transform(F, 6 + h, F.GATES[(m0 + F.lane) * 32 + 6 + h]);
        GC[F.lane] = gc; BE[F.lane] = be;
        const float eg = __expf(gc), gl63 = __shfl(gc, 63);
        float* gs = F.GSC + (size_t)item * 448; gs[F.lane] = be; gs[64 + F.lane] = be * eg; gs[128 + F.lane] = eg; gs[192 + F.lane] = __expf(gl63 - gc);
    } else if (F.wave == 6) {
        const float li = gate_transform(F, 12 + h, F.GATES[(m0 + F.lane) * 32 + 12 + h]);
        const float lf = gate_transform(F, 18 + h, F.GATES[(m0 + F.lane) * 32 + 18 + h]);
        const float bc = wave_incl_sum(lf, F.lane), a = li - bc, pm = wave_incl_max(a, F.lane);
        float* gs = F.GSC + (size_t)item * 448; gs[256 + F.lane] = a; gs[320 + F.lane] = pm; gs[384 + F.lane] = bc;
    }
    __syncthreads();
    if (mat < 3) {
        const int col = mat * 768 + h * 128 + ch * 8;
#pragma unroll
        for (int r = 0; r < 8; ++r) *(GAS v4u*)(F.PROJ + (m0 + 8 * rg + r) * NP + col) = ov[r];
    }
    {
        const int lane = F.lane, w = F.wave, lr = lane & 15, g = lane >> 4;
        unsigned char* chk = F.CHK + (size_t)item * CHK_STRIDE;
        for (int id = w; id < 20; id += 8) {
            const int kind = id >= 10 ? 1 : 0, idx = id - 10 * kind;
            const int it = idx >= 6 ? 3 : (idx >= 3 ? 2 : (idx >= 1 ? 1 : 0)), jt = idx - (it * (it + 1)) / 2;
            f32x4 acc = {0.f, 0.f, 0.f, 0.f};
#pragma unroll
            for (int ks = 0; ks < 4; ++ks) acc = MFMA16(row_frag(Ki, 16 * jt + lr, ks, g), row_frag(kind ? Qi : Ki, 16 * it + lr, ks, g), acc);
            const int i = 16 * it + lr;
            const float gci = GC[i], bei = BE[i];
            float val[4];
#pragma unroll
            for (int r = 0; r < 4; ++r) { const int j = 16 * jt + 4 * g + r; const float dec = __expf(gci - GC[j]);
                val[r] = kind ? (i >= j ? acc[r] * dec : 0.f) : (i > j ? bei * acc[r] * dec : 0.f); }
            if (kind) {
                v2u o; o.x = cvt_pk_bf16(val[0], val[1]); o.y = cvt_pk_bf16(val[2], val[3]);
                *(GAS v2u*)(chk + CHK_ATT + (size_t)i * 128 + (16 * jt + 4 * g) * 2) = o;
                if (jt == it && !(it & 1)) *(GAS v2u*)(chk + CHK_ATT + (size_t)i * 128 + (16 * (jt + 1) + 4 * g) * 2) = (v2u){0u, 0u};
            } else if (jt < it) {
                v2u o; o.x = cvt_pk_bf16(-val[0], -val[1]); o.y = cvt_pk_bf16(-val[2], -val[3]);
                *(GAS v2u*)(chk + CHK_NA + (size_t)i * 128 + (16 * jt + 4 * g) * 2) = o;
            } else {
                *(LAS f32x4*)(LB + it * 256 + lr * 16 + 4 * g) = (f32x4){val[0], val[1], val[2], val[3]};
                *(GAS v2u*)(chk + CHK_NA + (size_t)i * 128 + (16 * jt + 4 * g) * 2) = (v2u){0u, 0u};
            }
        }
        __syncthreads();
        if (w == 0) {
            const int blk = lane >> 4, col = lane & 15;
            const LAS float* L = LB + blk * 256;
            float xv[16];
#pragma unroll
            for (int i2 = 0; i2 < 16; ++i2) {
                float sacc = (i2 == col) ? 1.f : 0.f;
#pragma unroll
                for (int j2 = 0; j2 < i2; ++j2) sacc -= L[i2 * 16 + j2] * xv[j2];
                xv[i2] = sacc;
                *(GAS bf16*)(chk + CHK_DI + (size_t)(blk * 256 + i2 * 16 + col) * 2) = (bf16)f2bf(sacc);
            }
        }
        __syncthreads();
    }
}
DI void p2a_prep(Frame& F) {
    for (int it = F.vcu; it < BATCH * NCH * 6; it += F.G) gdn_prep_item(F, it);
}

DI void p2b1_light(Frame& F) {
    constexpr int N1 = 48 * NSEG, N2 = 2 * N1, N3 = N2 + BATCH * 4 * 16;
    for (int it = F.vcu; it < N3; it += F.G) { if (it < N1) gdn_light(F, it); else if (it < N2) mlstm_light(F, it - N1); else xattn_item(F, it - N2); }
}
DI void p2b2_combine(Frame& F) { if (F.vcu < 48) gdn_combine(F, F.vcu); else if (F.vcu < 96) mlstm_combine(F, F.vcu - 48); }
DI void p2b3_full(Frame& F) { constexpr int N1 = 48 * NSEG; for (int it = F.vcu; it < 2 * N1; it += F.G) { if (it < N1) gdn_item(F, it); else mlstm_item(F, it - N1); } }

struct Args { const float* in[15]; float* out; unsigned char* ws; int ph_lo, ph_hi, li, pad; };
__global__ void __launch_bounds__(NTHR, 2) hyb_fwd(Args args) {
    extern __shared__ __attribute__((aligned(16))) unsigned char lds[];
    Frame F;
    F.lds = (LAS unsigned char*)lds;
    F.MISC = (volatile LAS unsigned*)(F.lds + MISC_OFF);
    F.tid = threadIdx.x; F.lane = F.tid & 63; F.wave = __builtin_amdgcn_readfirstlane(F.tid >> 6);
    F.G = gridDim.x; { const int bx = blockIdx.x; F.vcu = (F.G % 8 == 0) ? (bx % 8) * (F.G / 8) + bx / 8 : bx; }
    unsigned char* ws = args.ws;
    F.ctl = (gu32*)(ws + WS_CTL);
    F.x = args.in[0]; F.mem = args.in[1]; F.norm_g = args.in[2]; F.w_in = args.in[3]; F.conv_w = args.in[4]; F.a_log = args.in[5]; F.dt_bias = args.in[6];
    F.gdn_ng = args.in[7]; F.i_bias = args.in[8]; F.f_bias = args.in[9]; F.ml_ng = args.in[10]; F.mem_ng = args.in[11]; F.w_kv = args.in[12]; F.w_out = args.in[13]; F.fin_g = args.in[14];
    F.out = args.out;
    F.HALO = (bf16*)((unsigned char*)args.out + DO_HALO); F.CHK = (unsigned char*)args.out + DO_CHK; F.GSC = (float*)((unsigned char*)args.out + DO_GSC); F.STML = (float*)((unsigned char*)args.out + DO_STML); F.STGD = (unsigned char*)args.out + DO_STGD; F.XN = (bf16*)((unsigned char*)args.out + DO_XN); F.WIN = (bf16*)((unsigned char*)args.out + DO_WIN);
    F.WOUT = (bf16*)(ws + WS_WOUT); F.KV = (bf16*)(ws + WS_KV); F.KM = F.KV; F.VT = F.KV + (size_t)MMEM * 512; F.GATES = (float*)(ws + WS_GATES); F.PROJ = (bf16*)(ws + WS_PROJ);
    for (int u = F.tid; u < (XTRA_OFF - LDSCTL_OFF) / 4; u += NTHR) ((LAS unsigned*)(F.lds + LDSCTL_OFF))[u] = 0u;
    __syncthreads();
    XcdBarrier bar; bar.bar = (unsigned*)(F.ctl + CW_BAR); bar.x = 0; bar.st = nullptr;
    if (N_LAUNCHES != PER_PHASE) bar = xcd_barrier_post((unsigned*)(F.ctl + CW_BAR), F.MISC + 8);
#define GRID_BAR(seam) do { if (N_LAUNCHES == PER_PHASE) { if (F.tid == 0) __hip_atomic_store(F.ctl + CW_TMO, 0xBADBA0u | (unsigned)(seam), RLX_AGENT); } else { xcd_barrier(bar); } } while (0)
#ifndef PROBE_A
#define PROBE_A (-1)
#define PROBE_B 0
#define PROBE_WG 0
#define PROBE_K 4
#endif
    unsigned long long ts_[8];
#define TS(i) do { if (PROBE_A >= 0) ts_[i] = __builtin_amdgcn_s_memrealtime(); } while (0)
    TS(0);
    const int lo = args.ph_lo, hi = args.ph_hi;
#define IN(k) (lo <= (k) && (k) < hi)
#define BOTH(k) (IN(k) && IN((k) + 1))
    if (IN(0)) { p0_prologue(F); if (BOTH(0)) GRID_BAR(0); }
    TS(1);
    if (IN(1)) { p1_gemm_in(F); if (BOTH(1)) GRID_BAR(1); }
    TS(2);
    if (IN(2)) { p2a_prep(F); GRID_BAR(5); TS(3); p2b1_light(F); GRID_BAR(6); p2b2_combine(F); GRID_BAR(7); p2b3_full(F); TS(4); if (BOTH(2)) GRID_BAR(2); }
    TS(5);
    if (IN(3)) { p3_gemm_out(F); if (BOTH(3)) GRID_BAR(3); }
    TS(6);
    if (IN(4)) { p4_final_norm(F); }
    TS(7);
    if (PROBE_A >= 0 && (int)blockIdx.x == PROBE_WG && F.tid == 0) {
        const unsigned long long dur = (ts_[PROBE_B] - ts_[PROBE_A < 0 ? 0 : PROBE_A]) * PROBE_K, t0 = __builtin_amdgcn_s_memrealtime();
        while (__builtin_amdgcn_s_memrealtime() - t0 < dur) __builtin_amdgcn_s_sleep(8);
    }
#undef IN
#undef BOTH
}

extern "C" void kernel_launch(void* const* d_in, const int* in_sizes, int n_in, void* d_out, int out_size, void* d_ws, size_t ws_size, hipStream_t stream) {
    static int grid = 0;
    if (grid == 0) {
        if (n_in != 15 || in_sizes[0] != MTOK * DM || out_size != MTOK * DM || ws_size < WS_END) { fprintf(stderr, "kernel_launch: unexpected shapes / workspace (%zu < %zu)\n", ws_size, (size_t)WS_END); grid = -1; return; }
        int dev = 0, cus = 0, per_cu = 0;
        if (hipGetDevice(&dev) != hipSuccess || hipDeviceGetAttribute(&cus, hipDeviceAttributeMultiprocessorCount, dev) != hipSuccess) { grid = -1; return; }
        if (hipFuncSetAttribute((const void*)hyb_fwd, hipFuncAttributeMaxDynamicSharedMemorySize, LDS_BYTES) != hipSuccess) { grid = -1; return; }
        if (hipOccupancyMaxActiveBlocksPerMultiprocessor(&per_cu, (const void*)hyb_fwd, NTHR, LDS_BYTES) != hipSuccess || per_cu < 1)
            fprintf(stderr, "kernel_launch: occupancy query reports %d workgroups per CU\n", per_cu);
        (void)hipGetLastError();
        grid = cus;
    }
    if (grid < 0) return;
    if (hipMemsetAsync((char*)d_ws + WS_CTL, 0, CTL_ZERO_BYTES, stream) != hipSuccess) return;
    Args a{};
    for (int i = 0; i < 15; ++i) a.in[i] = (const float*)d_in[i];
    a.out = (float*)d_out; a.ws = (unsigned char*)d_ws;
    const int nl = N_LAUNCHES == PER_PHASE ? PER_PHASE : 1;
    for (int li = 0; li < nl; ++li) {
        a.ph_lo = (N_LAUNCHES == PER_PHASE) ? li : 0; a.ph_hi = (N_LAUNCHES == PER_PHASE) ? li + 1 : PER_PHASE; a.li = li;
        hipLaunchKernelGGL(hyb_fwd, dim3(grid), dim3(NTHR), LDS_BYTES, stream, a);
        if (hipPeekAtLastError() != hipSuccess) break;
    }
}
```
